# Optimizing an MI355X kernel written in HIP

```python
import math
import jax, jax.numpy as jnp
from jax import lax
import numpy as np

D_MODEL = 2048
BATCH = 8
SEQ = 2048
DEPTH = 4

HEAD_DIM = 128
N_MIX_HEADS = D_MODEL // HEAD_DIM
N_MIXERS = 4
GROUP_HEADS = N_MIX_HEADS // N_MIXERS
GROUP_W = GROUP_HEADS * HEAD_DIM
MIX_W = N_MIXERS * GROUP_W
BLOCK_Q = 128
ROPE_THETA = 500000.0
FOX_HEADS = GROUP_HEADS
MLA_HEADS = GROUP_HEADS
MLA_Q_RANK = 384
MLA_KV_RANK = 256
MLA_NOPE = 128
MLA_ROPE = 64
MLA_V = 128
SGU_GROUPS = GROUP_HEADS
SGU_CH = HEAD_DIM
SGU_CHUNK = 128
DIFF_HEADS = GROUP_HEADS
DIFF_D = HEAD_DIM // 2
DIFF_ROT = DIFF_D // 4
MEM_LEN = 256
CROSS_HEADS = 4
CROSS_HEAD_DIM = 128
CROSS_W = CROSS_HEADS * CROSS_HEAD_DIM
FFN_HIDDEN = ((8 * D_MODEL // 3 + 255) // 256) * 256
EPS = 1e-6

IN_SIZES = (GROUP_W, GROUP_W, GROUP_W, FOX_HEADS,
            MLA_Q_RANK, MLA_KV_RANK, MLA_ROPE,
            2 * GROUP_W,
            GROUP_W, GROUP_W, GROUP_W)
N_IN = 3 * GROUP_W + FOX_HEADS + MLA_Q_RANK + MLA_KV_RANK + MLA_ROPE + 2 * GROUP_W + 3 * GROUP_W

kernel_name = 'hybrid_parallel_head_group_decoder'

F32 = jnp.float32


def rmsnorm(x, g):
    xf = x.astype(F32)
    y = xf * lax.rsqrt(jnp.mean(xf * xf, axis=-1, keepdims=True) + EPS)
    return (y * g.astype(F32)).astype(x.dtype)


def layernorm(x, g, b):
    xf = x.astype(F32)
    mu = jnp.mean(xf, axis=-1, keepdims=True)
    xc = xf - mu
    y = xc * lax.rsqrt(jnp.mean(xc * xc, axis=-1, keepdims=True) + EPS)
    return (y * g.astype(F32) + b.astype(F32)).astype(x.dtype)


def rope_tables(positions, rot_dim):
    freqs = ROPE_THETA ** (-jnp.arange(0, rot_dim, 2, dtype=F32) / rot_dim)
    ang = positions.astype(F32)[..., None] * freqs
    return jnp.cos(ang), jnp.sin(ang)


def apply_rope(x, cos, sin):
    half = cos.shape[-1]
    r = 2 * half
    c = cos[:, :, None, :].astype(x.dtype)
    s = sin[:, :, None, :].astype(x.dtype)
    x1, x2, xp = x[..., :half], x[..., half:r], x[..., r:]
    return jnp.concatenate([x1 * c - x2 * s, x1 * s + x2 * c, xp], axis=-1)


def _heads(a, h):
    b, s, _ = a.shape
    return a.reshape(b, s, h, -1)


def _bhsd(a):
    return a.transpose(0, 2, 1, 3)


def _merge(o):
    b, h, s, d = o.shape
    return o.transpose(0, 2, 1, 3).reshape(b, s, h * d)


def _to_blocks(a):
    b, h, s = a.shape[:3]
    a = a.reshape((b, h, s // BLOCK_Q, BLOCK_Q) + a.shape[3:])
    return jnp.moveaxis(a, 2, 0)


def _from_blocks(o):
    nb, b, h, blk, d = o.shape
    return jnp.moveaxis(o, 0, 2).reshape(b, h, nb * blk, d)


def _masked_softmax(scores, blk_idx):
    s = scores.shape[-1]
    q_pos = blk_idx * BLOCK_Q + jnp.arange(BLOCK_Q)
    mask = jnp.arange(s)[None, :] <= q_pos[:, None]
    return jax.nn.softmax(jnp.where(mask, scores, -jnp.inf), axis=-1)


def causal_attention(q, k, v, scale, log_decay=None):
    nb = q.shape[2] // BLOCK_Q
    xs = (jnp.arange(nb), _to_blocks(q))
    if log_decay is not None:
        xs = xs + (_to_blocks(log_decay),)

    def body(args):
        i, qb = args[0], args[1]
        sc = jnp.einsum('bhqd,bhkd->bhqk', qb, k).astype(F32) * scale
        if log_decay is not None:
            sc = sc + args[2].astype(F32)[..., None] - log_decay.astype(F32)[:, :, None, :]
        p = _masked_softmax(sc, i)
        return jnp.einsum('bhqk,bhkd->bhqd', p.astype(v.dtype), v)

    return _from_blocks(lax.map(body, xs))


def differential_attention(q1, q2, k1, k2, v, scale, lam):
    nb = q1.shape[2] // BLOCK_Q

    def body(args):
        i, q1b, q2b = args
        p1 = _masked_softmax(jnp.einsum('bhqd,bhkd->bhqk', q1b, k1).astype(F32) * scale, i)
        p2 = _masked_softmax(jnp.einsum('bhqd,bhkd->bhqk', q2b, k2).astype(F32) * scale, i)
        p = p1 - lam * p2
        return jnp.einsum('bhqk,bhkd->bhqd', p.astype(v.dtype), v)

    return _from_blocks(lax.map(body, (jnp.arange(nb), _to_blocks(q1), _to_blocks(q2))))


def fox_mixer(q, k, v, f_logit, b_f):
    log_f = jax.nn.log_sigmoid((f_logit + b_f).astype(F32))
    cum = jnp.cumsum(log_f, axis=1).transpose(0, 2, 1)
    o = causal_attention(_bhsd(_heads(q, FOX_HEADS)), _bhsd(_heads(k, FOX_HEADS)),
                         _bhsd(_heads(v, FOX_HEADS)), HEAD_DIM ** -0.5, cum)
    return _merge(o)


def mla_mixer(c_q, c_kv, k_rope, g_cq, g_ckv, w_uq, w_ukv, cos, sin):
    q = _heads(rmsnorm(c_q, g_cq) @ w_uq, MLA_HEADS)
    kv = _heads(rmsnorm(c_kv, g_ckv) @ w_ukv, MLA_HEADS)
    q = jnp.concatenate([q[..., :MLA_NOPE], apply_rope(q[..., MLA_NOPE:], cos, sin)], axis=-1)
    kr = apply_rope(k_rope[:, :, None, :], cos, sin)
    k = jnp.concatenate([kv[..., :MLA_NOPE],
                         jnp.broadcast_to(kr, kv.shape[:3] + (MLA_ROPE,))], axis=-1)
    v = kv[..., MLA_NOPE:]
    o = causal_attention(_bhsd(q), _bhsd(k), _bhsd(v), (MLA_NOPE + MLA_ROPE) ** -0.5)
    return _merge(o)


def sgu_mixer(uv, ln_g, ln_b, w_s, b_s):
    z = jax.nn.gelu(uv)
    u, v = z[..., :GROUP_W], z[..., GROUP_W:]
    v = layernorm(v, ln_g, ln_b)
    b, s, _ = v.shape
    v = v.reshape(b, s // SGU_CHUNK, SGU_CHUNK, SGU_GROUPS, SGU_CH)
    w = jnp.tril(w_s)
    mixed = jnp.einsum('gts,bnsgc->bntgc', w, v) + b_s.T[None, None, :, :, None]
    return u * mixed.reshape(b, s, GROUP_W)


def diff_mixer(q, k, v, lq1, lk1, lq2, lk2, g_diff, lam_init, cos, sin):
    q = _heads(q, DIFF_HEADS)
    k = _heads(k, DIFF_HEADS)
    v = _heads(v, DIFF_HEADS)
    q1 = apply_rope(q[..., :DIFF_D], cos, sin)
    q2 = apply_rope(q[..., DIFF_D:], cos, sin)
    k1 = apply_rope(k[..., :DIFF_D], cos, sin)
    k2 = apply_rope(k[..., DIFF_D:], cos, sin)
    lam = (jnp.exp(jnp.sum(lq1.astype(F32) * lk1.astype(F32)))
           - jnp.exp(jnp.sum(lq2.astype(F32) * lk2.astype(F32))) + lam_init)
    o = differential_attention(_bhsd(q1), _bhsd(q2), _bhsd(k1), _bhsd(k2), _bhsd(v),
                               DIFF_D ** -0.5, lam)
    o = rmsnorm(o, g_diff) * (1.0 - lam_init)
    return _merge(o)


def memory_cross_attention(xn, mem_n, w_q, w_k, w_v, w_o):
    q = _heads(xn @ w_q, CROSS_HEADS)
    k = _heads(mem_n @ w_k, CROSS_HEADS)
    v = _heads(mem_n @ w_v, CROSS_HEADS)
    sc = jnp.einsum('bshd,bmhd->bhsm', q, k).astype(F32) * CROSS_HEAD_DIM ** -0.5
    p = jax.nn.softmax(sc, axis=-1)
    o = jnp.einsum('bhsm,bmhd->bshd', p.astype(v.dtype), v)
    b, s = o.shape[:2]
    return o.reshape(b, s, CROSS_W) @ w_o


def swiglu(xn, w_gate, w_up, w_down):
    return (jax.nn.silu(xn @ w_gate) * (xn @ w_up)) @ w_down


def _split_points():
    pts, acc = [], 0
    for sz in IN_SIZES[:-1]:
        acc += sz
        pts.append(acc)
    return pts


def setup_inputs(seed: int = 0) -> dict:
    key = jax.random.key(seed)
    ks = jax.random.split(key, 32)

    def nrm(k, shape, scale):
        return jax.random.normal(k, shape, F32) * scale

    def gain(k, shape):
        return 1.0 + 0.02 * jax.random.normal(k, shape, F32)

    L, D = DEPTH, D_MODEL
    return {
        'x': nrm(ks[0], (BATCH, SEQ, D), 1.0),
        'mem': nrm(ks[1], (BATCH, MEM_LEN, D), 1.0),
        'positions': jnp.broadcast_to(jnp.arange(SEQ, dtype=jnp.int32)[None, :], (BATCH, SEQ)),
        'g_mix': gain(ks[2], (L, D)),
        'w_in': nrm(ks[3], (L, D, N_IN), D ** -0.5),
        'b_f': 3.0 + 0.5 * jax.random.normal(ks[4], (L, FOX_HEADS), F32),
        'g_cq': gain(ks[5], (L, MLA_Q_RANK)),
        'g_ckv': gain(ks[6], (L, MLA_KV_RANK)),
        'w_uq': nrm(ks[7], (L, MLA_Q_RANK, MLA_HEADS * (MLA_NOPE + MLA_ROPE)), MLA_Q_RANK ** -0.5),
        'w_ukv': nrm(ks[8], (L, MLA_KV_RANK, MLA_HEADS * (MLA_NOPE + MLA_V)), MLA_KV_RANK ** -0.5),
        'sgu_ln_g': gain(ks[9], (L, GROUP_W)),
        'sgu_ln_b': nrm(ks[10], (L, GROUP_W), 0.02),
        'w_s': nrm(ks[11], (L, SGU_GROUPS, SGU_CHUNK, SGU_CHUNK), SGU_CHUNK ** -0.5),
        'b_s': 1.0 + 0.1 * jax.random.normal(ks[12], (L, SGU_GROUPS, SGU_CHUNK), F32),
        'lam_q1': nrm(ks[13], (L, DIFF_D), 0.1),
        'lam_k1': nrm(ks[14], (L, DIFF_D), 0.1),
        'lam_q2': nrm(ks[15], (L, DIFF_D), 0.1),
        'lam_k2': nrm(ks[16], (L, DIFF_D), 0.1),
        'g_diff': gain(ks[17], (L, 2 * DIFF_D)),
        'w_o': nrm(ks[18], (L, MIX_W, D), MIX_W ** -0.5),
        'g_mem': gain(ks[19], (D,)),
        'g_cross': gain(ks[20], (L, D)),
        'w_cq': nrm(ks[21], (L, D, CROSS_W), D ** -0.5),
        'w_ck': nrm(ks[22], (L, D, CROSS_W), D ** -0.5),
        'w_cv': nrm(ks[23], (L, D, CROSS_W), D ** -0.5),
        'w_co': nrm(ks[24], (L, CROSS_W, D), CROSS_W ** -0.5),
        'g_ffn': gain(ks[25], (L, D)),
        'w_gate': nrm(ks[26], (L, D, FFN_HIDDEN), D ** -0.5),
        'w_up': nrm(ks[27], (L, D, FFN_HIDDEN), D ** -0.5),
        'w_down': nrm(ks[28], (L, FFN_HIDDEN, D), FFN_HIDDEN ** -0.5),
        'g_final': gain(ks[29], (D,)),
    }


def reference(x, mem, positions, g_mix, w_in, b_f, g_cq, g_ckv, w_uq, w_ukv, sgu_ln_g, sgu_ln_b,
              w_s, b_s, lam_q1, lam_k1, lam_q2, lam_k2, g_diff, w_o, g_mem, g_cross, w_cq, w_ck,
              w_cv, w_co, g_ffn, w_gate, w_up, w_down, g_final):
    cos_mla, sin_mla = rope_tables(positions, MLA_ROPE)
    cos_d, sin_d = rope_tables(positions, DIFF_ROT)
    mem_n = rmsnorm(mem, g_mem)
    pts = _split_points()
    for l in range(DEPTH):
        h = rmsnorm(x, g_mix[l])
        (fq, fk, fv, ff, cq, ckv, kr, uv, dq, dk, dv) = jnp.split(h @ w_in[l], pts, axis=-1)
        lam_init = 0.8 - 0.6 * math.exp(-0.3 * l)
        y_a = fox_mixer(fq, fk, fv, ff, b_f[l])
        y_b = mla_mixer(cq, ckv, kr, g_cq[l], g_ckv[l], w_uq[l], w_ukv[l], cos_mla, sin_mla)
        y_c = sgu_mixer(uv, sgu_ln_g[l], sgu_ln_b[l], w_s[l], b_s[l])
        y_d = diff_mixer(dq, dk, dv, lam_q1[l], lam_k1[l], lam_q2[l], lam_k2[l], g_diff[l],
                         lam_init, cos_d, sin_d)
        x = x + jnp.concatenate([y_a, y_b, y_c, y_d], axis=-1) @ w_o[l]
        x = x + memory_cross_attention(rmsnorm(x, g_cross[l]), mem_n, w_cq[l], w_ck[l], w_cv[l], w_co[l])
        x = x + swiglu(rmsnorm(x, g_ffn[l]), w_gate[l], w_up[l], w_down[l])
    return rmsnorm(x, g_final)
```

```cpp
#include <hip/hip_runtime.h>
#include <hip/hip_cooperative_groups.h>
#include <cstdio>
#include <cstdint>
namespace cg = cooperative_groups;

#define LAS __attribute__((address_space(3)))
#define GAS __attribute__((address_space(1)))
typedef unsigned short bf16_t;
typedef short bf16x8 __attribute__((ext_vector_type(8)));
typedef short s16x4 __attribute__((ext_vector_type(4)));
typedef float f32x4 __attribute__((ext_vector_type(4)));
typedef float f32x16 __attribute__((ext_vector_type(16)));
typedef unsigned u32x4 __attribute__((ext_vector_type(4)));
typedef unsigned u32x2 __attribute__((ext_vector_type(2)));

constexpr int DM = 2048, NB = 8, SEQ = 2048, DEPTH = 4, MTOK = NB * SEQ;
constexpr int NIN_SRC = 4804, NIN = 4864;
constexpr int FFH = 5632, MEMLEN = 256, MEMROWS = NB * MEMLEN;
constexpr int PC_FQ = 0, PC_FK = 512, PC_FV = 1024, PC_CQ = 1536, PC_CKV = 1920, PC_KR = 2176, PC_FF = 2240, PC_U = 2304, PC_V = 2816, PC_DQ = 3328, PC_DK = 3840, PC_DV = 4352;
constexpr float LOG2E = 1.4426950408889634f;
constexpr float EPSN = 1e-6f;

constexpr size_t al256(size_t x) { return (x + 255) & ~(size_t)255; }
constexpr size_t WS_CTL = 0, CTL_BYTES = 1u << 20;
constexpr size_t SZ_WIN = (size_t)NIN * DM * 2, SZ_UQ = 768 * 384 * 2, SZ_UKV = 1024 * 256 * 2, SZ_WS = 4 * 128 * 128 * 2, SZ_WO = (size_t)DM * DM * 2,
                 SZ_CQ = 512 * (size_t)DM * 2, SZ_CO = (size_t)DM * 512 * 2, SZ_GU = (size_t)2 * FFH * DM * 2, SZ_DN = (size_t)DM * FFH * 2;
constexpr size_t LW_WIN = 0, LW_UQ = LW_WIN + SZ_WIN, LW_UKV = LW_UQ + SZ_UQ, LW_WS = LW_UKV + SZ_UKV, LW_WO = LW_WS + SZ_WS, LW_CQ = LW_WO + SZ_WO,
                 LW_CO = LW_CQ + SZ_CQ, LW_GU = LW_CO + SZ_CO, LW_DN = LW_GU + SZ_GU, LW_STRIDE = LW_DN + SZ_DN;
constexpr size_t WS_LW = WS_CTL + CTL_BYTES;
constexpr size_t WS_KVCW = WS_LW + DEPTH * LW_STRIDE;
constexpr size_t WS_XN = WS_KVCW + (size_t)4096 * DM * 2;
constexpr size_t WS_P = WS_XN + (size_t)MTOK * DM * 2;
constexpr size_t WS_MIX = WS_P + (size_t)MTOK * NIN * 2;
constexpr size_t WS_HID = WS_P;
constexpr size_t WS_QM = WS_MIX + (size_t)MTOK * DM * 2;
constexpr size_t WS_KVM = WS_QM + (size_t)MTOK * 768 * 2;
constexpr size_t WS_QC = WS_KVM + (size_t)MTOK * 1024 * 2;
constexpr size_t WS_OC = WS_QC + (size_t)MTOK * 512 * 2;
constexpr size_t WS_KVC = WS_OC + (size_t)MTOK * 512 * 2;
constexpr size_t WS_MEMN = WS_KVC + (size_t)MEMROWS * 4096 * 2;
constexpr size_t WS_FF = WS_MEMN + (size_t)MEMROWS * DM * 2;
constexpr size_t WS_CUMF = WS_FF + (size_t)MTOK * 4 * 4;
constexpr size_t WS_RSQ = WS_CUMF + (size_t)32 * SEQ * 4;
constexpr size_t WS_RSKV = WS_RSQ + (size_t)MTOK * 12 * 4;
constexpr size_t WS_COSM = WS_RSKV + (size_t)MTOK * 8 * 4;
constexpr size_t WS_SINM = WS_COSM + (size_t)MTOK * 32 * 4;
constexpr size_t WS_COSD = WS_SINM + (size_t)MTOK * 32 * 4;
constexpr size_t WS_SIND = WS_COSD + (size_t)MTOK * 8 * 4;
constexpr size_t WS_RS = WS_SIND + (size_t)MTOK * 8 * 4;
constexpr size_t WS_END = WS_RS + (size_t)12 * MTOK * 8 * 4;
static_assert(WS_HID + (size_t)MTOK * FFH * 2 <= WS_QM, "HID overlay");
static_assert(LW_STRIDE % 256 == 0, "align");

constexpr int DUP_ATT = 0, DUP_PRO = 0, EXTRA_SYNC = 0, DUP_P12 = 0, DUP_P3 = 0, DUP_G = 0, DUP_P9 = 0;
constexpr int LDS_BYTES = 147456;
constexpr int LDSCTL_OFF = 131072;
constexpr int LDSP_OFF = 131072 + 1024;

__device__ __forceinline__ unsigned f2bf(float f) { unsigned u = __float_as_uint(f); return (u + 0x7fffu + ((u >> 16) & 1u)) >> 16; }
__device__ __forceinline__ unsigned pk2(float lo, float hi) { return f2bf(lo) | (f2bf(hi) << 16); }
__device__ __forceinline__ float bf2f(unsigned short h) { return __uint_as_float(((unsigned)h) << 16); }
__device__ __forceinline__ unsigned cvtpk(float lo, float hi) { unsigned r; asm volatile("v_cvt_pk_bf16_f32 %0, %1, %2" : "=v"(r) : "v"(lo), "v"(hi)); return r; }
__device__ __forceinline__ float wave_sum(float v) {
#pragma unroll
    for (int o = 1; o < 64; o <<= 1) v += __shfl_xor(v, o);
    return v;
}
__device__ __forceinline__ float gelu_tanh(float x) {
    const float y = 0.7978845608028654f * (x + 0.044715f * x * x * x);
    const float e = __builtin_amdgcn_exp2f(-2.0f * LOG2E * y);
    return x * __builtin_amdgcn_rcpf(1.0f + e);
}
__device__ __forceinline__ int opaque_tid() { int t = threadIdx.x; asm volatile("" : "+v"(t)); return t; }
template <class T> __device__ __forceinline__ T* launder(T* p) { asm volatile("" : "+s"(p)); return p; }
__device__ __forceinline__ int crow(int r, int hi) { return (r & 3) + 8 * (r >> 2) + 4 * hi; }

namespace pg8 {
constexpr int BM = 256, BK = 64, HALF = 128, HTB = HALF * BK * 2, STAGE_BYTES = 8 * HTB, NXCD = 8, WGM = 8;
__host__ __device__ __forceinline__ int lds_byte(int r, int c) { const int st = (r >> 4) * 2 + (c >> 5), rr = r & 15, cc = c & 31, ob = rr * 64 + cc * 2; return st * 1024 + (ob ^ (((ob >> 9) & 1) << 5)); }
__host__ __device__ __forceinline__ void stage_rc(int b, int& R, int& C) { const int st = b / 1024, sb = b % 1024, swz = sb ^ (((sb >> 9) & 1) << 5); R = (st >> 1) * 16 + swz / 64; C = (st & 1) * 32 + (swz % 64) / 2; }
__host__ __device__ __forceinline__ int perm32(int rho) { const int n = rho >> 4, i = rho & 15; return 8 * (i >> 2) + 4 * n + (i & 3); }
struct Unit { int pm, pn; };
struct Gemm { const bf16_t* A; const bf16_t* Bt; int M, N, K, lda, ldb; };
struct StaticOrder {
    int nM, nN, nwg, G, c;
    __device__ void init(int M, int N, int G_, int c_) { nM = M / BM; nN = N / BM; nwg = nM * nN; G = G_; c = c_; }
    __device__ bool next(int i, Unit& u) const {
        const long L = (long)i * G + c; if (L >= nwg) return false;
        int wgid = (int)L; { const int q = nwg / NXCD, r = nwg % NXCD, xcd = wgid % NXCD, off = wgid / NXCD; wgid = (xcd < r ? xcd * (q + 1) : r * (q + 1) + (xcd - r) * q) + off; }
        const int nig = WGM * nN, gid = wgid / nig, fm = gid * WGM, gsz = (nM - fm) < WGM ? (nM - fm) : WGM;
        u.pm = fm + ((wgid % nig) % gsz); u.pn = (wgid % nig) / gsz; return true;
    }
};
template <class Epi, class Sched>
__device__ __forceinline__ void gemm_phase(LAS unsigned char* lds, const Gemm g, const Sched& S, const Epi& E) {
    const int tid = opaque_tid(), wid = __builtin_amdgcn_readfirstlane(tid >> 6), lane = tid & 63, wr = wid >> 2, wc = wid & 3, fr = lane & 15, fq = lane >> 4;
    const int K = g.K, nt = K / BK;
    unsigned voffA[2], voffB[2];
#pragma unroll
    for (int i = 0; i < 2; ++i) { int R, C; stage_rc(tid * 16 + i * 8192, R, C); const int Rb = Epi::PERM ? ((R & ~31) + perm32(R & 31)) : R;
        voffA[i] = (unsigned)(R * g.lda + C) * 2u; voffB[i] = (unsigned)(Rb * g.ldb + C) * 2u; }
    const size_t kstep = (size_t)(BK * 2);
    const size_t hstepA = (size_t)HALF * g.lda * 2, hstepB = (size_t)HALF * g.ldb * 2;
    const size_t tstepA = 2 * hstepA, tstepB = 2 * hstepB;
    const unsigned ldsw = (unsigned)wid * 1024u;
    const int aoff = lds_byte(wr * 64 + fr, fq * 8), boff = lds_byte(wc * 32 + fr, fq * 8);
#define PG8_SA(b, h) (((b) * 2 + (h)) * HTB)
#define PG8_SB(b, h) ((4 + (b) * 2 + (h)) * HTB)
#define PG8_STAGE(bufoff, gbase, voff) do { _Pragma("unroll") for (int _i = 0; _i < 2; ++_i) \
        __builtin_amdgcn_global_load_lds((const unsigned*)((const char*)(gbase) + (voff)[_i]), (LAS unsigned*)(lds + (bufoff) + ldsw + _i * 8192), 16, 0, 0); } while (0)
#define PG8_LDA(dst, b, h) do { _Pragma("unroll") for (int m = 0; m < 4; ++m) _Pragma("unroll") for (int k = 0; k < 2; ++k) dst[m][k] = *(const LAS bf16x8*)(lds + PG8_SA(b, h) + aoff + m * 2048 + k * 1024); } while (0)
#define PG8_LDB(dst, b, h) do { _Pragma("unroll") for (int n = 0; n < 2; ++n) _Pragma("unroll") for (int k = 0; k < 2; ++k) dst[n][k] = *(const LAS bf16x8*)(lds + PG8_SB(b, h) + boff + n * 2048 + k * 1024); } while (0)
#define PG8_MMA(ai, bj, At, Bt) do { __builtin_amdgcn_s_setprio(1); _Pragma("unroll") for (int m = 0; m < 4; ++m) _Pragma("unroll") for (int n = 0; n < 2; ++n) _Pragma("unroll") for (int k = 0; k < 2; ++k) \
        acc[ai][bj][m][n] = __builtin_amdgcn_mfma_f32_16x16x32_bf16(Bt[n][k], At[m][k], acc[ai][bj][m][n], 0, 0, 0); __builtin_amdgcn_s_setprio(0); } while (0)
#define PG8_WAIT_V(n) asm volatile("s_waitcnt vmcnt(" #n ")" ::: "memory")
#define PG8_WAIT_L(n) asm volatile("s_waitcnt lgkmcnt(" #n ")" ::: "memory")
#define PG8_BAR __builtin_amdgcn_s_barrier()
#define PG8_SCHED __builtin_amdgcn_sched_barrier(0)
    Unit cur, nxt; int ui = 0;
    if (!S.next(0, cur)) return;
    constexpr bool SC = Epi::SC8;
    LAS float* scb = (LAS float*)(lds + 139264);
    f32x4 pqa = (f32x4){0.f, 0.f, 0.f, 0.f}, pqb = (f32x4){0.f, 0.f, 0.f, 0.f};
#define PG8_SC_ISSUE(U) do { if (SC && tid < 256 && E.sc_rowsq()) { const float* rp_ = E.sc_rowsq() + (size_t)((U).pm * 256 + tid) * 8; pqa = *(const GAS f32x4*)rp_; pqb = *(const GAS f32x4*)(rp_ + 4); } } while (0)
#define PG8_SC_COMMIT(b_) do { if (SC && tid < 256) { float v_ = 1.f; if (E.sc_rowsq()) v_ = __builtin_amdgcn_rsqf((((pqa.x + pqa.y) + (pqa.z + pqa.w)) + ((pqb.x + pqb.y) + (pqb.z + pqb.w))) * E.sc_inv_n() + EPSN); scb[(b_) * 256 + tid] = v_; } } while (0)
    PG8_SC_ISSUE(cur); PG8_SC_COMMIT(0);
    f32x4 acc[2][2][4][2];
#pragma unroll
    for (int a = 0; a < 2; ++a)
#pragma unroll
        for (int b = 0; b < 2; ++b)
#pragma unroll
            for (int m = 0; m < 4; ++m)
#pragma unroll
                for (int n = 0; n < 2; ++n) acc[a][b][m][n] = (f32x4){0.f, 0.f, 0.f, 0.f};
    bf16x8 At[4][2], B0[2][2], B1[2][2];
    const char* cA = (const char*)g.A + (size_t)cur.pm * tstepA; const char* cB = (const char*)g.Bt + (size_t)cur.pn * tstepB;
    PG8_STAGE(PG8_SB(0, 0), cB, voffB); PG8_STAGE(PG8_SB(0, 1), cB + hstepB, voffB); PG8_STAGE(PG8_SA(0, 0), cA, voffA); PG8_STAGE(PG8_SA(0, 1), cA + hstepA, voffA);
    if (wr == 1) PG8_BAR;
    PG8_WAIT_V(2); PG8_BAR;
    PG8_STAGE(PG8_SB(1, 0), cB + kstep, voffB); PG8_STAGE(PG8_SA(1, 0), cA + kstep, voffA); PG8_STAGE(PG8_SB(1, 1), cB + hstepB + kstep, voffB);
    PG8_WAIT_V(6); PG8_BAR;
    for (;;) {
        const bool has_next = S.next(ui + 1, nxt);
        const char* nA = has_next ? (const char*)g.A + (size_t)nxt.pm * tstepA : cA; const char* nB = has_next ? (const char*)g.Bt + (size_t)nxt.pn * tstepB : cB;
        for (int t = 0; t < nt; t += 2) {
            const bool last = (t == nt - 2);
            const char* a1 = cA + (size_t)(t + 1) * kstep;
            const char* a2 = last ? nA : cA + (size_t)(t + 2) * kstep; const char* b2 = last ? nB : cB + (size_t)(t + 2) * kstep;
            const char* a3 = a2 + kstep; const char* b3 = b2 + kstep;
            PG8_LDB(B0, 0, 0); PG8_LDB(B1, 0, 1); PG8_SCHED; PG8_LDA(At, 0, 0); PG8_STAGE(PG8_SA(1, 1), a1 + hstepA, voffA);
            PG8_WAIT_V(8); PG8_WAIT_L(0); PG8_BAR; PG8_MMA(0, 0, At, B0); PG8_MMA(0, 1, At, B1); PG8_BAR; PG8_SCHED;
            PG8_LDA(At, 0, 1); PG8_STAGE(PG8_SB(0, 0), b2, voffB); PG8_STAGE(PG8_SB(0, 1), b2 + hstepB, voffB); PG8_STAGE(PG8_SA(0, 0), a2, voffA);
            PG8_WAIT_V(8); PG8_WAIT_L(0); PG8_BAR; PG8_MMA(1, 0, At, B0); PG8_MMA(1, 1, At, B1); PG8_BAR; PG8_SCHED;
            PG8_LDB(B0, 1, 0); PG8_LDB(B1, 1, 1); PG8_SCHED; PG8_LDA(At, 1, 0); PG8_STAGE(PG8_SA(0, 1), a2 + hstepA, voffA);
            PG8_WAIT_V(8); PG8_WAIT_L(0); PG8_BAR; PG8_MMA(0, 0, At, B0); PG8_MMA(0, 1, At, B1); PG8_BAR; PG8_SCHED;
            PG8_LDA(At, 1, 1); PG8_STAGE(PG8_SB(1, 0), b3, voffB); PG8_STAGE(PG8_SB(1, 1), b3 + hstepB, voffB); PG8_STAGE(PG8_SA(1, 0), a3, voffA);
            PG8_WAIT_V(8); PG8_WAIT_L(0); PG8_BAR; PG8_MMA(1, 0, At, B0); PG8_MMA(1, 1, At, B1); PG8_BAR; PG8_SCHED;
        }
        if (wr == 0) PG8_BAR;
        if (has_next) PG8_SC_ISSUE(nxt);
        { const int l2 = opaque_tid() & 63; E(acc, cur, wr, wc, l2 & 15, l2 >> 4, (const LAS float*)(scb + (ui & 1) * 256)); }
        if (has_next) PG8_SC_COMMIT((ui + 1) & 1);
        if (!has_next) break;
#pragma unroll
        for (int a = 0; a < 2; ++a)
#pragma unroll
            for (int b = 0; b < 2; ++b)
#pragma unroll
                for (int m = 0; m < 4; ++m)
#pragma unroll
                    for (int n = 0; n < 2; ++n) acc[a][b][m][n] = (f32x4){0.f, 0.f, 0.f, 0.f};
        cur = nxt; cA = nA; cB = nB; ++ui;
        if (wr == 1) PG8_BAR;
    }
    PG8_WAIT_V(0);
    PG8_BAR;
#undef PG8_SC_ISSUE
#undef PG8_SC_COMMIT
#undef PG8_SA
#undef PG8_SB
#undef PG8_STAGE
#undef PG8_LDA
#undef PG8_LDB
#undef PG8_MMA
#undef PG8_WAIT_V
#undef PG8_WAIT_L
#undef PG8_BAR
#undef PG8_SCHED
}
}

struct EpiBf16G {
    static constexpr bool PERM = true, SC8 = true;
    __device__ __forceinline__ const float* sc_rowsq() const { return rowsq; }
    __device__ __forceinline__ float sc_inv_n() const { return inv_n; }
    bf16_t* O; int ldc; const float* rowsq; float inv_n; int mode; int p8;
    const float* cosM; const float* sinM; const float* cosD; const float* sinD; float* ff;
    __device__ __forceinline__ void operator()(const f32x4 (&acc)[2][2][4][2], const pg8::Unit& u, int wr, int wc, int fr, int fq, const LAS float* scr) const {
        const int row0 = u.pm * 256 + wr * 64 + fr;
#pragma unroll
        for (int bj = 0; bj < 2; ++bj) {
            const int c0 = u.pn * 256 + bj * 128 + wc * 32, col0 = c0 + 8 * fq;
            int kind = 0, j0 = 0; bool ffw = false;
            if (mode == 1) {
                if (c0 >= PC_KR && c0 < PC_KR + 64) { kind = 1; j0 = ((c0 - PC_KR) >> 1) + 4 * fq; }
                else if (c0 >= PC_DQ && c0 < PC_DV && (c0 & 63) == 0 && fq < 2) { kind = 2; j0 = 4 * fq; }
                ffw = (c0 == PC_FF) && (fq == 0);
            } else if (mode == 2) {
                if (((c0 & ~63) % 192) == 128) { kind = 1; j0 = ((c0 & 32) ? 16 : 0) + 4 * fq; }
            }
#pragma unroll
            for (int ai = 0; ai < 2; ++ai)
#pragma unroll
                for (int m = 0; m < 4; ++m) {
                    const int row = row0 + ai * 128 + m * 16;
                    const float sc_ = scr[ai * 128 + wr * 64 + m * 16 + fr]; f32x4 v0 = acc[ai][bj][m][0] * sc_, v1 = acc[ai][bj][m][1] * sc_;
                    if (kind == 1) { const f32x4 c = *(const GAS f32x4*)(cosM + (size_t)row * 32 + j0), s = *(const GAS f32x4*)(sinM + (size_t)row * 32 + j0);
                        const f32x4 a = v0 * c - v1 * s, b = v0 * s + v1 * c; v0 = a; v1 = b; }
                    else if (kind == 2) { const f32x4 c = *(const GAS f32x4*)(cosD + (size_t)row * 8 + j0), s = *(const GAS f32x4*)(sinD + (size_t)row * 8 + j0);
                        const f32x4 a = v0 * c - v1 * s, b = v0 * s + v1 * c; v0 = a; v1 = b; }
                    if (ffw) *(GAS f32x4*)(ff + (size_t)row * 4) = v0;
                    if (mode == 1 && c0 >= PC_CQ && c0 < PC_KR) {
                        float ss = ((v0.x * v0.x + v0.y * v0.y) + (v0.z * v0.z + v0.w * v0.w)) + ((v1.x * v1.x + v1.y * v1.y) + (v1.z * v1.z + v1.w * v1.w));
                        ss += __shfl_xor(ss, 16); ss += __shfl_xor(ss, 32);
                        float* lsq = ff + (WS_RSQ - WS_FF) / 4; float* lskv = ff + (WS_RSKV - WS_FF) / 4;
                        if (fq == 0) { if (c0 < PC_CKV) *(GAS float*)(lsq + (size_t)row * 12 + ((c0 - PC_CQ) >> 5)) = ss; else *(GAS float*)(lskv + (size_t)row * 8 + ((c0 - PC_CKV) >> 5)) = ss; } }
                    u32x4 w; w.x = cvtpk(v0[0], v0[1]); w.y = cvtpk(v0[2], v0[3]); w.z = cvtpk(v1[0], v1[1]); w.w = cvtpk(v1[2], v1[3]);
                    *(GAS u32x4*)(O + (size_t)row * ldc + col0) = w;
                    if ((m & 1) || kind) asm volatile("" ::: "memory");
                }
        }
    }
};
template <int NP, bool ROPE> struct EpiLat {
    static constexpr bool PERM = true, SC8 = false;
    __device__ __forceinline__ const float* sc_rowsq() const { return nullptr; }
    __device__ __forceinline__ float sc_inv_n() const { return 0.f; }
    bf16_t* O; int ldc; const float* part; float inv_n; const float* cosM; const float* sinM;
    __device__ __forceinline__ void operator()(const f32x4 (&acc)[2][2][4][2], const pg8::Unit& u, int wr, int wc, int fr, int fq, const LAS float* scr) const {
        const int row0 = u.pm * 256 + wr * 64 + fr;
#pragma unroll
        for (int ai = 0; ai < 2; ++ai)
#pragma unroll
            for (int m = 0; m < 4; ++m) { const int row = row0 + ai * 128 + m * 16; const float* rp = part + (size_t)row * NP; float q = 0.f;
#pragma unroll
                for (int j = 0; j < NP / 4; ++j) { const f32x4 t = *(const GAS f32x4*)(rp + 4 * j); q += (t.x + t.y) + (t.z + t.w); }
                const float sc = __builtin_amdgcn_rsqf(q * inv_n + EPSN);
#pragma unroll
                for (int bj = 0; bj < 2; ++bj) { const int c0 = u.pn * 256 + bj * 128 + wc * 32, col0 = c0 + 8 * fq;
                    f32x4 v0 = acc[ai][bj][m][0] * sc, v1 = acc[ai][bj][m][1] * sc;
                    if (ROPE && ((c0 & ~63) % 192) == 128) { const int j0 = ((c0 & 32) ? 16 : 0) + 4 * fq;
                        const f32x4 c = *(const GAS f32x4*)(cosM + (size_t)row * 32 + j0), s = *(const GAS f32x4*)(sinM + (size_t)row * 32 + j0);
                        const f32x4 a = v0 * c - v1 * s, b = v0 * s + v1 * c; v0 = a; v1 = b; }
                    u32x4 w; w.x = cvtpk(v0[0], v0[1]); w.y = cvtpk(v0[2], v0[3]); w.z = cvtpk(v1[0], v1[1]); w.w = cvtpk(v1[2], v1[3]);
                    *(GAS u32x4*)(O + (size_t)row * ldc + col0) = w; }
                if (m & 1) asm volatile("" ::: "memory"); }
    }
};
struct EpiRes {
    static constexpr bool PERM = true, SC8 = false;
    __device__ __forceinline__ const float* sc_rowsq() const { return nullptr; }
    __device__ __forceinline__ float sc_inv_n() const { return 0.f; }
    bf16_t* xb; int ldc; float* rsp; LAS float* ldsp;
    __device__ __forceinline__ void operator()(const f32x4 (&acc)[2][2][4][2], const pg8::Unit& u, int wr, int wc, int fr, int fq, const LAS float* scr) const {
        const int row0 = u.pm * 256 + wr * 64 + fr, col0 = u.pn * 256 + wc * 32 + 8 * fq;
        u32x4 pre[2][4][2];
#pragma unroll
        for (int ai = 0; ai < 2; ++ai)
#pragma unroll
            for (int m = 0; m < 4; ++m)
#pragma unroll
                for (int bj = 0; bj < 2; ++bj) pre[ai][m][bj] = *(const GAS u32x4*)(xb + (size_t)(row0 + ai * 128 + m * 16) * ldc + col0 + bj * 128);
#pragma unroll
        for (int ai = 0; ai < 2; ++ai)
#pragma unroll
            for (int m = 0; m < 4; ++m) { float ss = 0.f;
#pragma unroll
                for (int bj = 0; bj < 2; ++bj) { const u32x4 p = pre[ai][m][bj]; const f32x4 a0 = acc[ai][bj][m][0], a1 = acc[ai][bj][m][1];
                    const float v0 = __uint_as_float(p.x << 16) + a0.x, v1 = __uint_as_float(p.x & 0xffff0000u) + a0.y, v2 = __uint_as_float(p.y << 16) + a0.z, v3 = __uint_as_float(p.y & 0xffff0000u) + a0.w;
                    const float v4 = __uint_as_float(p.z << 16) + a1.x, v5 = __uint_as_float(p.z & 0xffff0000u) + a1.y, v6 = __uint_as_float(p.w << 16) + a1.z, v7 = __uint_as_float(p.w & 0xffff0000u) + a1.w;
                    ss += ((v0 * v0 + v1 * v1) + (v2 * v2 + v3 * v3)) + ((v4 * v4 + v5 * v5) + (v6 * v6 + v7 * v7));
                    u32x4 w; w.x = cvtpk(v0, v1); w.y = cvtpk(v2, v3); w.z = cvtpk(v4, v5); w.w = cvtpk(v6, v7);
                    *(GAS u32x4*)(xb + (size_t)(row0 + ai * 128 + m * 16) * ldc + col0 + bj * 128) = w; }
                ss += __shfl_xor(ss, 16); ss += __shfl_xor(ss, 32);
                if (fq == 0) ldsp[(ai * 128 + wr * 64 + m * 16 + fr) * 4 + wc] = ss; }
        asm volatile("s_waitcnt lgkmcnt(0)" ::: "memory"); __builtin_amdgcn_s_barrier(); asm volatile("" ::: "memory");
        const int t = (wr * 4 + wc) * 64 + fq * 16 + fr;
        if (t < 256) { const f32x4 p = *(const LAS f32x4*)(ldsp + t * 4); *(GAS float*)(rsp + (size_t)(u.pm * 256 + t) * 8 + u.pn) = (p.x + p.y) + (p.z + p.w); }
        asm volatile("s_waitcnt lgkmcnt(0)" ::: "memory"); __builtin_amdgcn_s_barrier(); asm volatile("" ::: "memory");
    }
};
struct EpiSwiglu {
    static constexpr bool PERM = true, SC8 = true;
    __device__ __forceinline__ const float* sc_rowsq() const { return rowsq; }
    __device__ __forceinline__ float sc_inv_n() const { return 1.0f / DM; }
    bf16_t* H; int ldc; const float* rowsq;
    __device__ __forceinline__ void operator()(const f32x4 (&acc)[2][2][4][2], const pg8::Unit& u, int wr, int wc, int fr, int fq, const LAS float* scr) const {
        const int row0 = u.pm * 256 + wr * 64 + fr, col0 = u.pn * 128 + wc * 32 + 8 * fq;
#pragma unroll
        for (int ai = 0; ai < 2; ++ai)
#pragma unroll
            for (int m = 0; m < 4; ++m) { const int row = row0 + ai * 128 + m * 16; float r[8]; const float s_ = scr[ai * 128 + wr * 64 + m * 16 + fr];
                const float k_ = -LOG2E * s_, s2_ = s_ * s_;
#pragma unroll
                for (int n = 0; n < 2; ++n)
#pragma unroll
                    for (int i = 0; i < 4; ++i) { const float g_ = acc[ai][0][m][n][i], u_ = acc[ai][1][m][n][i];
                        r[n * 4 + i] = (g_ * u_) * (s2_ * __builtin_amdgcn_rcpf(1.0f + __builtin_amdgcn_exp2f(g_ * k_))); }
                typedef float f32x2_ __attribute__((ext_vector_type(2))); typedef __bf16 bf16x2_ __attribute__((ext_vector_type(2)));
                u32x4 w;
                { const f32x2_ a0 = {r[0], r[1]}, a1 = {r[2], r[3]}, a2 = {r[4], r[5]}, a3 = {r[6], r[7]};
                  w.x = __builtin_bit_cast(unsigned, __builtin_convertvector(a0, bf16x2_)); w.y = __builtin_bit_cast(unsigned, __builtin_convertvector(a1, bf16x2_));
                  w.z = __builtin_bit_cast(unsigned, __builtin_convertvector(a2, bf16x2_)); w.w = __builtin_bit_cast(unsigned, __builtin_convertvector(a3, bf16x2_)); }
                *(GAS u32x4*)(H + (size_t)row * ldc + col0) = w; }
    }
};
template <class Epi> __device__ __forceinline__ void run_gemm(LAS unsigned char* lds, const bf16_t* A, int lda, const bf16_t* Bt, int ldb, int M, int N, int K, const Epi& E) {
    pg8::Gemm g{A, Bt, M, N, K, lda, ldb}; pg8::StaticOrder S; S.init(M, N, (int)gridDim.x, (int)blockIdx.x);
    pg8::gemm_phase<Epi, pg8::StaticOrder>(lds, g, S, E);
}

namespace att {
constexpr int SHM_V = 64 * 128 * 2, SHM_KMAX = 64 * 192 * 2;
constexpr int OFF_K = 2 * SHM_V, OFF_FK = OFF_K + 2 * SHM_KMAX, OFF_WS = OFF_FK + 512, ATT_LDS = OFF_WS + 8 * 64 * 4;
#define SBAR() __builtin_amdgcn_sched_barrier(0)
__device__ __forceinline__ int v_st(int k, int c) { const int kk = (k & ~0xC) | ((k & 4) << 1) | ((k & 8) >> 1); return ((kk >> 3) * 4 + (c >> 5)) * 512 + ((kk & 7) * 32 + (c & 31)) * 2; }
__device__ __forceinline__ int v_rd_base(int lane) { return ((lane & 3) << 3) | (((lane >> 2) & 3) << 6) | (((lane >> 4) & 1) << 5) | (((lane >> 5) & 1) << 8); }
constexpr int v_rd_off(int d0, int ks, int half) { return d0 * 512 + ks * 4096 + half * 2048; }

__device__ __forceinline__ void pv_tile(f32x16* o, int vb0, bf16x8 pa0, bf16x8 pa1, bf16x8 pa2, bf16x8 pa3) {
#define TRRD(dst, off) asm volatile("ds_read_b64_tr_b16 %0, %1 offset:%2" : "=&v"(dst) : "v"(vb0), "i"(off) : "memory")
#define RD8(L, H, ks) do { TRRD(L[0], v_rd_off(0, ks, 0)); TRRD(H[0], v_rd_off(0, ks, 1)); TRRD(L[1], v_rd_off(1, ks, 0)); TRRD(H[1], v_rd_off(1, ks, 1)); \
                           TRRD(L[2], v_rd_off(2, ks, 0)); TRRD(H[2], v_rd_off(2, ks, 1)); TRRD(L[3], v_rd_off(3, ks, 0)); TRRD(H[3], v_rd_off(3, ks, 1)); } while (0)
#define MM4(PA, L, H) do { _Pragma("unroll") for (int d0 = 0; d0 < 4; ++d0) \
        o[d0] = __builtin_amdgcn_mfma_f32_32x32x16_bf16(PA, (bf16x8){L[d0][0], L[d0][1], L[d0][2], L[d0][3], H[d0][0], H[d0][1], H[d0][2], H[d0][3]}, o[d0], 0, 0, 0); } while (0)
    s16x4 la[4], ha[4], lb[4], hb[4];
    RD8(la, ha, 0);
    RD8(lb, hb, 1); asm volatile("s_waitcnt lgkmcnt(8)" ::: "memory"); SBAR(); MM4(pa0, la, ha); SBAR();
    RD8(la, ha, 2); asm volatile("s_waitcnt lgkmcnt(8)" ::: "memory"); SBAR(); MM4(pa1, lb, hb); SBAR();
    RD8(lb, hb, 3); asm volatile("s_waitcnt lgkmcnt(8)" ::: "memory"); SBAR(); MM4(pa2, la, ha); SBAR();
    asm volatile("s_waitcnt lgkmcnt(0)" ::: "memory"); SBAR(); MM4(pa3, lb, hb);
#undef MM4
#undef RD8
#undef TRRD
}

template <int DK, int MODE>
__device__ __forceinline__ void attn_pass(LAS char* lds, const bf16_t* Qw, int qpitch, const bf16_t* Kb, int kpitch, const bf16_t* Kb2, int k2pitch,
                                          const bf16_t* Vb, int vpitch, const float* Fk, float Fq, int NT, int qlo, float C2, f32x16 (&o)[4]) {
    const int tid = opaque_tid(), wid = __builtin_amdgcn_readfirstlane(tid >> 6), lane = tid & 63, r32 = lane & 31, hi = lane >> 5;
    constexpr int PITCH = DK * 2, CPR = DK / 8, NKC = (64 * CPR) / 512, SHM_K = 64 * PITCH, ND = DK / 16;
    LAS char* V_lds = lds; LAS char* K_lds = lds + OFF_K; LAS float* fk_l = (LAS float*)(lds + OFF_FK); LAS float* ws = (LAS float*)(lds + OFF_WS) + wid * 64;
    bf16x8 qr[ND];
#pragma unroll
    for (int d0 = 0; d0 < ND; ++d0) qr[d0] = *(const GAS bf16x8*)(Qw + (size_t)r32 * qpitch + d0 * 16 + hi * 8);
    constexpr int NKI = (64 * PITCH) / 8192;
    const GAS bf16_t* kp[NKI]; int kstep[NKI];
#pragma unroll
    for (int i = 0; i < NKI; ++i) { const int off = (wid * NKI + i) * 1024 + lane * 16, row = off / PITCH, rem = off % PITCH, p = rem >> 4, ch = (p & ~7) | ((p & 7) ^ (row & 7));
        if (DK <= 128 || ch < 16) { kp[i] = (const GAS bf16_t*)Kb + (size_t)row * kpitch + ch * 8; kstep[i] = 64 * kpitch; }
        else { kp[i] = (const GAS bf16_t*)Kb2 + (size_t)row * k2pitch + (ch - 16) * 8; kstep[i] = 64 * k2pitch; } }
    const GAS bf16_t* vp[2];
#pragma unroll
    for (int i = 0; i < 2; ++i) { const int off = (wid * 2 + i) * 1024 + lane * 16, sub = off >> 9, rem = off & 511, kk = (sub >> 2) * 8 + (rem >> 6), kq = (kk & ~0xC) | ((kk & 4) << 1) | ((kk & 8) >> 1), c = (sub & 3) * 32 + ((rem & 63) >> 1);
        vp[i] = (const GAS bf16_t*)Vb + (size_t)kq * vpitch + c; }
    const int vstep = 64 * vpitch;
#define A_LOAD(t, bf) do { _Pragma("unroll") for (int i = 0; i < NKI; ++i) \
            __builtin_amdgcn_global_load_lds((const GAS unsigned*)(kp[i] + (size_t)(t) * kstep[i]), (LAS unsigned*)(K_lds + (bf) * SHM_K + (wid * NKI + i) * 1024), 16, 0, 0); \
        _Pragma("unroll") for (int i = 0; i < 2; ++i) \
            __builtin_amdgcn_global_load_lds((const GAS unsigned*)(vp[i] + (size_t)(t) * vstep), (LAS unsigned*)(V_lds + (bf) * SHM_V + (wid * 2 + i) * 1024), 16, 0, 0); \
        if (MODE == 1) __builtin_amdgcn_global_load_lds((const GAS unsigned*)(Fk + (t) * 64 + lane), (LAS unsigned*)(fk_l + (bf) * 64), 4, 0, 0); } while (0)
    float m_reg = -1e30f, l_reg = 0.f;
#pragma unroll
    for (int d = 0; d < 4; ++d) o[d] = f32x16{};
    const int vb00 = (int)(uintptr_t)V_lds + v_rd_base(lane);
    A_LOAD(0, 0); asm volatile("s_waitcnt vmcnt(0) lgkmcnt(0)\n\ts_barrier" ::: "memory");
    for (int t = 0; t < NT; ++t) {
        const int buf = t & 1, kb = t * 64;
        if (t + 1 < NT) A_LOAD(t + 1, buf ^ 1);
        const bool act = (MODE == 2) || (kb <= qlo + 31);
        if (act) {
            f32x16 p0 = f32x16{}, p1 = f32x16{};
            const LAS char* kbase = K_lds + buf * SHM_K + r32 * PITCH;
#pragma unroll
            for (int d0 = 0; d0 < ND; ++d0) {
                const LAS char* a = kbase + (((d0 * 32 + hi * 16) ^ ((r32 & 7) << 4)));
                const bf16x8 b0 = *(const LAS bf16x8*)a, b1 = *(const LAS bf16x8*)(a + 32 * PITCH);
                p0 = __builtin_amdgcn_mfma_f32_32x32x16_bf16(b0, qr[d0], p0, 0, 0, 0);
                p1 = __builtin_amdgcn_mfma_f32_32x32x16_bf16(b1, qr[d0], p1, 0, 0, 0);
            }
            if (MODE == 1) {
#pragma unroll
                for (int g = 0; g < 4; ++g) { const f32x4 fa = *(const LAS f32x4*)(fk_l + buf * 64 + 8 * g + 4 * hi), fb = *(const LAS f32x4*)(fk_l + buf * 64 + 32 + 8 * g + 4 * hi);
#pragma unroll
                    for (int i = 0; i < 4; ++i) { p0[4 * g + i] = fmaf(p0[4 * g + i], C2, Fq - fa[i]); p1[4 * g + i] = fmaf(p1[4 * g + i], C2, Fq - fb[i]); } }
            }
            if (MODE != 2 && kb + 63 > qlo) {
                const float NEG = -__builtin_inff(); const int dq = qlo + r32 - kb - 4 * hi;
#pragma unroll
                for (int r = 0; r < 16; ++r) { const int c = (r & 3) + 8 * (r >> 2); if (c > dq) p0[r] = NEG; if (c + 32 > dq) p1[r] = NEG; }
            }
            float pmax = p0[0];
#pragma unroll
            for (int r = 1; r < 16; ++r) pmax = fmaxf(pmax, p0[r]);
#pragma unroll
            for (int r = 0; r < 16; ++r) pmax = fmaxf(pmax, p1[r]);
            { auto rr = __builtin_amdgcn_permlane32_swap(__float_as_uint(pmax), __float_as_uint(pmax), false, false); pmax = fmaxf(__uint_as_float(rr[0]), __uint_as_float(rr[1])); }
            const float mn = fmaxf(m_reg, (MODE == 1) ? pmax : pmax * C2); const float alpha = __builtin_amdgcn_exp2f(m_reg - mn); m_reg = mn;
            float ps = 0.f;
#pragma unroll
            for (int r = 0; r < 16; ++r) { p0[r] = __builtin_amdgcn_exp2f((MODE == 1) ? p0[r] - mn : fmaf(p0[r], C2, -mn)); p1[r] = __builtin_amdgcn_exp2f((MODE == 1) ? p1[r] - mn : fmaf(p1[r], C2, -mn)); ps += p0[r] + p1[r]; }
            { auto rr = __builtin_amdgcn_permlane32_swap(__float_as_uint(ps), __float_as_uint(ps), false, false); ps = __uint_as_float(rr[0]) + __uint_as_float(rr[1]); }
            l_reg = l_reg * alpha + ps;
            bf16x8 pa0, pa1, pa2, pa3;
#define PK4(P, B_, OUT) do { unsigned a0 = cvtpk(P[B_ + 0], P[B_ + 1]), a1 = cvtpk(P[B_ + 2], P[B_ + 3]); unsigned b0 = cvtpk(P[B_ + 4], P[B_ + 5]), b1 = cvtpk(P[B_ + 6], P[B_ + 7]); \
        auto r0 = __builtin_amdgcn_permlane32_swap(a0, b0, false, false); auto r1 = __builtin_amdgcn_permlane32_swap(a1, b1, false, false); \
        u32x4 w = {r0[0], r1[0], r0[1], r1[1]}; OUT = *reinterpret_cast<bf16x8*>(&w); } while (0)
            PK4(p0, 0, pa0); PK4(p0, 8, pa1); PK4(p1, 0, pa2); PK4(p1, 8, pa3);
#undef PK4
            if (__any(alpha < 1.f)) { if (hi == 0) ws[r32] = alpha; asm volatile("s_waitcnt lgkmcnt(0)" ::: "memory");
#pragma unroll
                for (int r = 0; r < 16; ++r) { const float al = ws[crow(r, hi)];
#pragma unroll
                    for (int d = 0; d < 4; ++d) o[d][r] *= al; } }
            SBAR();
            pv_tile(o, vb00 + buf * SHM_V, pa0, pa1, pa2, pa3);
        }
        asm volatile("s_waitcnt vmcnt(0) lgkmcnt(0)\n\ts_barrier" ::: "memory");
    }
    if (hi == 0) ws[32 + r32] = l_reg; asm volatile("s_waitcnt lgkmcnt(0)" ::: "memory");
#pragma unroll
    for (int r = 0; r < 16; ++r) { const float rl = __builtin_amdgcn_rcpf(ws[32 + crow(r, hi)]);
#pragma unroll
        for (int d = 0; d < 4; ++d) o[d][r] *= rl; }
    asm volatile("s_waitcnt lgkmcnt(0)" ::: "memory");
#undef A_LOAD
}
__device__ __forceinline__ void store_o(const f32x16 (&o)[4], bf16_t* Ow, int pitch, int r32, int hi) {
#pragma unroll
    for (int r = 0; r < 16; ++r) { const int orow = crow(r, hi);
#pragma unroll
        for (int d0 = 0; d0 < 4; ++d0) { const float v = o[d0][r]; const float vn = __shfl_xor(v, 1);
            if ((r32 & 1) == 0) *(GAS unsigned*)(Ow + (size_t)orow * pitch + d0 * 32 + r32) = cvtpk(v, vn); } }
}
#undef SBAR
}

#define XB_TMO      128
#define XB_XCNT(j)  (256  + 64 * (j))
#define XB_XSUB(j)  (1280 + 64 * (j))
#define XB_XGEN(j)  (2304 + 64 * (j))
#define XB_TOP      3328
#define XB_TOPGEN   3392
#define XCD_BAR_WORDS 3456
#define XB_SPIN_CAP (1u << 20)
__device__ __forceinline__ unsigned xb_ld(unsigned* p)              { return __hip_atomic_load(p, __ATOMIC_RELAXED, __HIP_MEMORY_SCOPE_AGENT); }
__device__ __forceinline__ unsigned xb_add(unsigned* p, unsigned v) { return __hip_atomic_fetch_add(p, v, __ATOMIC_RELAXED, __HIP_MEMORY_SCOPE_AGENT); }
__device__ __forceinline__ unsigned xb_xcc_id() { return (unsigned)__builtin_amdgcn_s_getreg((3 << 11) | 20) & 0xFu; }
#define XB_SPIN(cond, bar) do { unsigned _sp = 0; while (cond) { __builtin_amdgcn_s_sleep(1); \
    if ((++_sp & 255u) == 0u) { if (xb_ld(&(bar)[XB_TMO])) break; if (_sp > XB_SPIN_CAP) { atomicAdd(&(bar)[XB_TMO], 1u); break; } } } } while (0)
struct XcdBarrier { unsigned* bar; unsigned x; volatile LAS unsigned* st; };
__device__ __forceinline__ XcdBarrier xcd_barrier_post(unsigned* bar, volatile LAS unsigned* st) {
    XcdBarrier b; b.bar = bar; b.x = xb_xcc_id(); b.st = st;
    if (threadIdx.x == 0) (void)xb_add(&bar[XB_XCNT(b.x)], 1u);
    return b;
}
__device__ __forceinline__ void xcd_barrier_complete(unsigned* bar, unsigned x, unsigned& nloc, unsigned& nx) {
    const unsigned G = gridDim.x * gridDim.y * gridDim.z;
    unsigned sum, cnt, mine, sp = 0u;
    for (;;) {
        sum = 0u; cnt = 0u; mine = 0u;
#pragma unroll
        for (unsigned j = 0; j < 16; ++j) { const unsigned c = xb_ld(&bar[XB_XCNT(j)]); sum += c; cnt += (c > 0u) ? 1u : 0u; mine = (j == x) ? c : mine; }
        if (sum == G) break;
        __builtin_amdgcn_s_sleep(1);
        if ((++sp & 255u) == 0u) { if (xb_ld(&bar[XB_TMO])) break; if (sp > XB_SPIN_CAP) { atomicAdd(&bar[XB_TMO], 1u); break; } }
    }
    nloc = mine > 0u ? mine : 1u; nx = cnt > 0u ? cnt : 1u;
}
__device__ __forceinline__ void xcd_barrier(const XcdBarrier& b) {
    asm volatile("s_waitcnt vmcnt(0)" ::: "memory");
    __syncthreads();
    if (threadIdx.x == 0) {
        unsigned* bar = b.bar;
        __builtin_amdgcn_s_waitcnt(0);
        unsigned nloc = b.st[0], nx = b.st[1];
        if (nloc == 0u) { xcd_barrier_complete(bar, b.x, nloc, nx); b.st[0] = nloc; b.st[1] = nx; }
        const unsigned old = xb_add(&bar[XB_XSUB(b.x)], 1u);
        const unsigned gen = old / nloc;
        if (old + 1u == (gen + 1u) * nloc) {
            __builtin_amdgcn_fence(__ATOMIC_RELEASE, "agent");
            asm volatile("s_waitcnt vmcnt(0)" ::: "memory");
            const unsigned og = xb_add(&bar[XB_TOP], 1u);
            const unsigned tg = og / nx;
            if (og + 1u == (tg + 1u) * nx) xb_add(&bar[XB_TOPGEN], 1u);
            else XB_SPIN(xb_ld(&bar[XB_TOPGEN]) == tg, bar);
            __builtin_amdgcn_fence(__ATOMIC_ACQUIRE, "agent");
            xb_add(&bar[XB_XGEN(b.x)], 1u);
            asm volatile("s_waitcnt vmcnt(0)" ::: "memory");
        } else {
            XB_SPIN(xb_ld(&bar[XB_XGEN(b.x)]) == gen, bar);
            __builtin_amdgcn_fence(__ATOMIC_ACQUIRE, "agent");
            asm volatile("s_waitcnt vmcnt(0)" ::: "memory");
        }
    }
    __syncthreads();
}

struct Args { const void* in[31]; float* out; unsigned char* ws; };

__device__ __forceinline__ int ropeperm64(int p) { return 4 * (p >> 3) + (p & 3) + 32 * ((p >> 2) & 1); }
__device__ __forceinline__ int ropeperm16(int w) { return 4 * (w >> 3) + (w & 3) + 8 * ((w >> 2) & 1); }
__device__ __forceinline__ int win_src(int n) {
    if (n < 1536) return n;
    if (n < 1920) return 1540 + (n - 1536);
    if (n < 2176) return 1924 + (n - 1920);
    if (n < 2240) return 2180 + ropeperm64(n - 2176);
    if (n < 2244) return 1536 + (n - 2240);
    if (n < 2304) return -1;
    if (n < 3328) return 2244 + (n - 2304);
    if (n < 4352) { const int p = n - 3328, w = p & 63; return 3268 + (p & ~63) + (w < 16 ? ropeperm16(w) : w); }
    return 4292 + (n - 4352);
}
struct TrItem { const float* W; const float* ksc; bf16_t* WT; int ldw, src, K, n0, k0; };
__device__ __forceinline__ void tr_load(const TrItem& d, f32x4 (&v)[8], int lane) {
#pragma unroll
    for (int i = 0; i < 8; ++i) { const int kk = 8 * i + (lane >> 3); v[i] = (f32x4){0.f, 0.f, 0.f, 0.f}; if (d.src >= 0) v[i] = __builtin_nontemporal_load((const GAS f32x4*)(d.W + (size_t)(d.k0 + kk) * d.ldw + d.src)); if (d.ksc) v[i] = v[i] * *(const GAS float*)(d.ksc + d.k0 + kk); }
}
__device__ __forceinline__ void tr_store(const TrItem& d, const f32x4 (&v)[8], LAS float* scr, int lane) {
#pragma unroll
    for (int i = 0; i < 8; ++i) { const int kk = 8 * i + (lane >> 3); LAS float* q = scr + kk * 33 + (lane & 7) * 4; q[0] = v[i].x; q[1] = v[i].y; q[2] = v[i].z; q[3] = v[i].w; }
    asm volatile("s_waitcnt lgkmcnt(0)" ::: "memory");
    const int c = lane & 7;
#pragma unroll
    for (int j = 0; j < 4; ++j) { const int n = (lane >> 3) + 8 * j; const LAS float* s = scr + (8 * c) * 33 + n;
        u32x4 o; o.x = pk2(s[0 * 33], s[1 * 33]); o.y = pk2(s[2 * 33], s[3 * 33]); o.z = pk2(s[4 * 33], s[5 * 33]); o.w = pk2(s[6 * 33], s[7 * 33]);
        *(GAS u32x4*)(d.WT + (size_t)(d.n0 + n) * d.K + d.k0 + 8 * c) = o; }
    asm volatile("s_waitcnt lgkmcnt(0)" ::: "memory");
}
__device__ __forceinline__ void rms_rows_bf16(const float* x, const float* g, bf16_t* out, int nrows, int gw, int ngw, int lane) {
    for (int m = gw; m < nrows; m += ngw) {
        const f32x4* xr = (const f32x4*)(x + (size_t)m * DM) + lane; f32x4 v[8]; float s = 0.f;
#pragma unroll
        for (int j = 0; j < 8; ++j) { v[j] = xr[64 * j]; s += (v[j].x * v[j].x + v[j].y * v[j].y) + (v[j].z * v[j].z + v[j].w * v[j].w); }
        const float rstd = 1.0f / sqrtf(wave_sum(s) * (1.0f / DM) + EPSN);
        u32x2* o8 = (u32x2*)(out + (size_t)m * DM) + lane;
#pragma unroll
        for (int j = 0; j < 8; ++j) { const f32x4 gj = ((const f32x4*)g)[lane + 64 * j]; u32x2 w; w.x = pk2(v[j].x * rstd * gj.x, v[j].y * rstd * gj.y); w.y = pk2(v[j].z * rstd * gj.z, v[j].w * rstd * gj.w); o8[64 * j] = w; }
    }
}

constexpr int IPL = 4864 + 144 + 128 + 2048 + 512 + 1024 + 512 + 11264 + 5632;

#define PH_IDS() const int tid = opaque_tid(), lane = tid & 63, wave = __builtin_amdgcn_readfirstlane(tid >> 6), r32 = lane & 31, hi = lane >> 5; \
    const int G = gridDim.x, gw = blockIdx.x * 8 + wave, ngw = G * 8; (void)r32; (void)hi; (void)gw; (void)ngw; (void)G
#define INP(T, k) ((const T*)launder(a.in[k]))
#define WSP(T, off) ((T*)(ws + (off)))

__device__ __forceinline__ void ph_prologue(const Args& a, char* lds) {
    PH_IDS(); unsigned char* ws = launder(a.ws);
    LAS float* scr = (LAS float*)((LAS unsigned char*)lds + wave * 16384);
    const float* w_in = INP(float, 4); const float* w_uq = INP(float, 8); const float* w_ukv = INP(float, 9); const float* w_o = INP(float, 19);
    const float* w_cq = INP(float, 22); const float* w_ck = INP(float, 23); const float* w_cv = INP(float, 24); const float* w_co = INP(float, 25);
    const float* w_gate = INP(float, 27); const float* w_up = INP(float, 28); const float* w_down = INP(float, 29);
    const float* g_cq = INP(float, 6); const float* g_ckv = INP(float, 7); const float* g_mix = INP(float, 3); const float* g_cross = INP(float, 21); const float* g_ffn = INP(float, 26);
    bf16_t* KVCW = WSP(bf16_t, WS_KVCW);
#define TR_DECODE(it_, D_) do { const int l = (it_) / IPL; int r = (it_) - l * IPL; unsigned char* lw = ws + WS_LW + (size_t)l * LW_STRIDE; const int ln = (lane & 7) * 4; int nblk; D_.ksc = nullptr; \
        if (r < 4864) { nblk = 152; D_.W = w_in + (size_t)l * DM * NIN_SRC; D_.ldw = NIN_SRC; D_.K = DM; D_.ksc = g_mix + l * DM; D_.WT = (bf16_t*)(lw + LW_WIN); D_.src = win_src((r % 152) * 32 + ln); } \
        else if ((r -= 4864) < 144) { nblk = 24; const int n = (r % 24) * 32 + ln, h = n / 192, w = n % 192; D_.src = (w < 128) ? n : h * 192 + 128 + ropeperm64(w - 128); \
            D_.W = w_uq + (size_t)l * 384 * 768; D_.ldw = 768; D_.K = 384; D_.ksc = g_cq + l * 384; D_.WT = (bf16_t*)(lw + LW_UQ); } \
        else if ((r -= 144) < 128) { nblk = 32; D_.W = w_ukv + (size_t)l * 256 * 1024; D_.ldw = 1024; D_.K = 256; D_.ksc = g_ckv + l * 256; D_.WT = (bf16_t*)(lw + LW_UKV); D_.src = (r % 32) * 32 + ln; } \
        else if ((r -= 128) < 2048) { nblk = 64; D_.W = w_o + (size_t)l * DM * DM; D_.ldw = DM; D_.K = DM; D_.WT = (bf16_t*)(lw + LW_WO); D_.src = (r % 64) * 32 + ln; } \
        else if ((r -= 2048) < 512) { nblk = 16; D_.W = w_cq + (size_t)l * DM * 512; D_.ldw = 512; D_.K = DM; D_.ksc = g_cross + l * DM; D_.WT = (bf16_t*)(lw + LW_CQ); D_.src = (r % 16) * 32 + ln; } \
        else if ((r -= 512) < 1024) { nblk = 32; const int nb = r % 32; D_.W = ((nb < 16) ? w_ck : w_cv) + (size_t)l * DM * 512; D_.ldw = 512; D_.K = DM; D_.WT = KVCW + (size_t)l * 1024 * DM; D_.src = (nb & 15) * 32 + ln; } \
        else if ((r -= 1024) < 512) { nblk = 64; D_.W = w_co + (size_t)l * 512 * DM; D_.ldw = DM; D_.K = 512; D_.WT = (bf16_t*)(lw + LW_CO); D_.src = (r % 64) * 32 + ln; } \
        else if ((r -= 512) < 11264) { nblk = 352; const int n = (r % 352) * 32, t = n >> 8, rr = n & 255; D_.W = ((rr < 128) ? w_gate : w_up) + (size_t)l * DM * FFH; D_.ldw = FFH; D_.K = DM; D_.ksc = g_ffn + l * DM; \
            D_.WT = (bf16_t*)(lw + LW_GU); D_.src = 128 * t + (rr & 127) + ln; } \
        else { r -= 11264; nblk = 64; D_.W = w_down + (size_t)l * FFH * DM; D_.ldw = DM; D_.K = FFH; D_.WT = (bf16_t*)(lw + LW_DN); D_.src = (r % 64) * 32 + ln; } \
        D_.n0 = (r % nblk) * 32; D_.k0 = (r / nblk) * 64; } while (0)
    if (gw < DEPTH * IPL) {
        TrItem cur; f32x4 v[8]; int it = gw;
        TR_DECODE(it, cur); tr_load(cur, v, lane);
        for (;;) {
            const int nx = it + ngw; const bool more = nx < DEPTH * IPL;
            TrItem nd = cur; f32x4 vn[8];
            if (more) { TR_DECODE(nx, nd); tr_load(nd, vn, lane); }
            tr_store(cur, v, scr, lane);
            if (!more) break;
            cur = nd; it = nx;
#pragma unroll
            for (int i = 0; i < 8; ++i) v[i] = vn[i];
        }
    }
#undef TR_DECODE
    const float* w_s = INP(float, 12);
    for (int i = blockIdx.x * 512 + tid; i < DEPTH * 4 * 128 * 128; i += G * 512) { const int l = i >> 16, rem = i & 65535, t = (rem >> 7) & 127, s = rem & 127;
        ((bf16_t*)(ws + WS_LW + (size_t)l * LW_STRIDE + LW_WS))[rem] = (bf16_t)f2bf(s <= t ? w_s[i] : 0.f); }
    const int* positions = INP(int, 2);
    float* COSM = WSP(float, WS_COSM); float* SINM = WSP(float, WS_SINM); float* COSD = WSP(float, WS_COSD); float* SIND = WSP(float, WS_SIND);
    for (int i = blockIdx.x * 512 + tid; i < MTOK * 40; i += G * 512) { const int row = i / 40, j = i % 40; const float pos = (float)positions[row];
        const bool isM = j < 32; const int jj = isM ? j : j - 32; const float ex = isM ? (float)jj * (1.0f / 32.0f) : (float)jj * (1.0f / 8.0f);
        const float freq = exp2f(-ex * 18.931568569324174f);
        const float ang = pos * freq; const double rev = (double)ang * 0.15915494309189535; const float fr = (float)(rev - rint(rev));
        const float c = __builtin_amdgcn_cosf(fr), sn = __builtin_amdgcn_sinf(fr);
        if (isM) { COSM[(size_t)row * 32 + jj] = c; SINM[(size_t)row * 32 + jj] = sn; } else { COSD[(size_t)row * 8 + jj] = c; SIND[(size_t)row * 8 + jj] = sn; } }
    rms_rows_bf16(INP(float, 1), INP(float, 20), WSP(bf16_t, WS_MEMN), MEMROWS, gw, ngw, lane);
    { const float* x = INP(float, 0); bf16_t* XB = WSP(bf16_t, WS_XN); float* RS0 = WSP(float, WS_RS);
      for (int m = gw; m < MTOK; m += ngw) {
        const f32x4* xr = (const f32x4*)(x + (size_t)m * DM) + lane; f32x4 v[8]; float sq = 0.f;
#pragma unroll
        for (int j = 0; j < 8; ++j) { v[j] = __builtin_nontemporal_load((const GAS f32x4*)(xr + 64 * j)); sq += (v[j].x * v[j].x + v[j].y * v[j].y) + (v[j].z * v[j].z + v[j].w * v[j].w); }
        sq = wave_sum(sq); if (lane < 8) RS0[(size_t)m * 8 + lane] = (lane == 0) ? sq : 0.f;
        u32x2* o8 = (u32x2*)(XB + (size_t)m * DM) + lane;
#pragma unroll
        for (int j = 0; j < 8; ++j) { u32x2 w; w.x = pk2(v[j].x, v[j].y); w.y = pk2(v[j].z, v[j].w); o8[64 * j] = w; }
      } }
}

__device__ __forceinline__ void ph_misc(const Args& a, char* lds, int l) {
    PH_IDS(); unsigned char* ws = launder(a.ws);
    const bf16_t* P = WSP(bf16_t, WS_P); bf16_t* MIX = WSP(bf16_t, WS_MIX);
    const float* FF = WSP(float, WS_FF); float* CUMF = WSP(float, WS_CUMF);
    if (wave == 0) {
#pragma unroll 1
        for (int b = 0; b < NB; ++b) {
            const int owner = (G >= 256) ? 192 + 8 * b : b % G;
            if ((int)blockIdx.x != owner) continue;
            const f32x4 bf = *(const f32x4*)(INP(float, 5) + l * 4); float c0 = 0.f, c1 = 0.f, c2 = 0.f, c3 = 0.f;
#pragma unroll 4
            for (int jj = 0; jj < SEQ / 64; ++jj) { const int pos = jj * 64 + lane; const f32x4 y = *(const GAS f32x4*)(FF + (size_t)(b * SEQ + pos) * 4) + bf;
                float s0 = fminf(y.x, 0.f) - __logf(1.0f + __expf(-fabsf(y.x))), s1 = fminf(y.y, 0.f) - __logf(1.0f + __expf(-fabsf(y.y)));
                float s2 = fminf(y.z, 0.f) - __logf(1.0f + __expf(-fabsf(y.z))), s3 = fminf(y.w, 0.f) - __logf(1.0f + __expf(-fabsf(y.w)));
#pragma unroll
                for (int o = 1; o < 64; o <<= 1) { const float t0 = __shfl_up(s0, o), t1 = __shfl_up(s1, o), t2 = __shfl_up(s2, o), t3 = __shfl_up(s3, o); if (lane >= o) { s0 += t0; s1 += t1; s2 += t2; s3 += t3; } }
                *(GAS float*)(CUMF + (size_t)(b * 4 + 0) * SEQ + pos) = (c0 + s0) * LOG2E; *(GAS float*)(CUMF + (size_t)(b * 4 + 1) * SEQ + pos) = (c1 + s1) * LOG2E;
                *(GAS float*)(CUMF + (size_t)(b * 4 + 2) * SEQ + pos) = (c2 + s2) * LOG2E; *(GAS float*)(CUMF + (size_t)(b * 4 + 3) * SEQ + pos) = (c3 + s3) * LOG2E;
                c0 += __shfl(s0, 63); c1 += __shfl(s1, 63); c2 += __shfl(s2, 63); c3 += __shfl(s3, 63); }
        }
    }
    const bf16_t* WSb = (const bf16_t*)(ws + WS_LW + (size_t)l * LW_STRIDE + LW_WS);
    const float* sgu_g = INP(float, 10); const float* sgu_b = INP(float, 11); const float* b_s = INP(float, 13);
    for (int u = blockIdx.x; u < 512; u += G) {
        const int g = u & 3, bn = u >> 2; const size_t row0 = (size_t)bn * 128;
        LAS char* Vt = (LAS char*)lds;
        const bool mine = (lane >> 4) == g; const int cl = (lane & 15) * 8;
        float gg[8], bb[8];
#pragma unroll
        for (int k = 0; k < 8; ++k) { gg[k] = sgu_g[l * 512 + g * 128 + cl + k]; bb[k] = sgu_b[l * 512 + g * 128 + cl + k]; }
        for (int i = 0; i < 16; i += 2) { const int s0 = wave * 16 + i, s1 = s0 + 1;
            const bf16x8 va = *(const GAS bf16x8*)(P + (row0 + s0) * NIN + PC_V + lane * 8), vb = *(const GAS bf16x8*)(P + (row0 + s1) * NIN + PC_V + lane * 8);
            float za[8], zb[8]; float suma = 0.f, sqa = 0.f, sumb = 0.f, sqb = 0.f;
#pragma unroll
            for (int k = 0; k < 8; ++k) { za[k] = gelu_tanh(bf2f((unsigned short)va[k])); zb[k] = gelu_tanh(bf2f((unsigned short)vb[k])); suma += za[k]; sqa += za[k] * za[k]; sumb += zb[k]; sqb += zb[k] * zb[k]; }
#pragma unroll
            for (int o = 1; o < 64; o <<= 1) { const float t0 = __shfl_xor(suma, o), t1 = __shfl_xor(sqa, o), t2 = __shfl_xor(sumb, o), t3 = __shfl_xor(sqb, o); suma += t0; sqa += t1; sumb += t2; sqb += t3; }
            const float meana = suma * (1.0f / 512.0f), meanb = sumb * (1.0f / 512.0f);
            const float rstda = 1.0f / sqrtf(fmaxf(sqa * (1.0f / 512.0f) - meana * meana, 0.f) + EPSN), rstdb = 1.0f / sqrtf(fmaxf(sqb * (1.0f / 512.0f) - meanb * meanb, 0.f) + EPSN);
            if (mine) {
#pragma unroll
                for (int k = 0; k < 8; ++k) { *(LAS bf16_t*)(Vt + (cl + k) * 272 + s0 * 2) = (bf16_t)f2bf((za[k] - meana) * rstda * gg[k] + bb[k]);
                                              *(LAS bf16_t*)(Vt + (cl + k) * 272 + s1 * 2) = (bf16_t)f2bf((zb[k] - meanb) * rstdb * gg[k] + bb[k]); } } }
        __syncthreads();
        const int tb = wave & 3, cb0 = (wave >> 2) * 2; f32x16 acc[2]; acc[0] = f32x16{}; acc[1] = f32x16{};
#pragma unroll
        for (int ks = 0; ks < 8; ++ks) if (16 * ks <= 32 * tb + 31) {
            const bf16x8 A = *(const bf16x8*)(WSb + ((size_t)g * 128 + 32 * tb + r32) * 128 + 16 * ks + 8 * hi);
#pragma unroll
            for (int ci = 0; ci < 2; ++ci) { const bf16x8 B = *(const LAS bf16x8*)(Vt + (32 * (cb0 + ci) + r32) * 272 + (16 * ks + 8 * hi) * 2); acc[ci] = __builtin_amdgcn_mfma_f32_32x32x16_bf16(A, B, acc[ci], 0, 0, 0); } }
#pragma unroll
        for (int ci = 0; ci < 2; ++ci)
#pragma unroll
            for (int r = 0; r < 16; ++r) { const int t = 32 * tb + crow(r, hi), c = 32 * (cb0 + ci) + r32; const size_t row = row0 + t;
                const float uval = gelu_tanh(bf2f(P[row * NIN + PC_U + g * 128 + c])); const float val = uval * (acc[ci][r] + b_s[l * 512 + g * 128 + t]);
                const float vn = __shfl_xor(val, 1); if ((r32 & 1) == 0) *(unsigned*)(MIX + row * DM + 1024 + g * 128 + c) = cvtpk(val, vn); }
        __syncthreads();
    }
}

__device__ __forceinline__ void ph_attn(const Args& a, char* lds, int l, int rep) {
    PH_IDS(); unsigned char* ws = launder(a.ws);
    const bf16_t* P = WSP(bf16_t, WS_P); bf16_t* MIX = WSP(bf16_t, WS_MIX);
    volatile LAS unsigned* ldsctl = (volatile LAS unsigned*)((LAS char*)lds + LDSCTL_OFF);
    const float lam_init = 0.8f - 0.6f * expf(-0.3f * (float)l);
    const float* lq1 = INP(float, 14); const float* lk1 = INP(float, 15); const float* lq2 = INP(float, 16); const float* lk2 = INP(float, 17);
    float d1 = 0.f, d2 = 0.f;
    for (int i = 0; i < 64; ++i) { d1 += lq1[l * 64 + i] * lk1[l * 64 + i]; d2 += lq2[l * 64 + i] * lk2[l * 64 + i]; }
    const float lam = expf(d1) - expf(d2) + lam_init;
    unsigned* ctr = WSP(unsigned, WS_CTL) + 64 * (1 + l + 8 * rep);
    for (;;) {
        if (tid == 0) ldsctl[0] = atomicAdd(ctr, 1u);
        __syncthreads();
        const int u = (int)ldsctl[0];
        __syncthreads();
        if (u >= 768) break;
        const int qb = 7 - u / 96, within = u % 96, type = within >> 5, bh = within & 31, b = bh >> 2, h = bh & 3;
        const size_t brow = (size_t)b * SEQ, qrow = brow + qb * 256 + wave * 32; const int qlo = qb * 256 + wave * 32, NT = 4 * (qb + 1);
        f32x16 o[4];
#ifndef SK_FOX
        if (type == 2) {
            const float* Fk = WSP(float, WS_CUMF) + (size_t)bh * SEQ;
            att::attn_pass<128, 1>((LAS char*)lds, P + qrow * NIN + PC_FQ + h * 128, NIN, P + brow * NIN + PC_FK + h * 128, NIN, nullptr, 0, P + brow * NIN + PC_FV + h * 128, NIN,
                                   Fk, Fk[qlo + r32], NT, qlo, 0.08838834764831845f * LOG2E, o);
            att::store_o(o, MIX + qrow * DM + h * 128, DM, r32, hi);
        } else
#endif
#ifndef SK_MLA
        if (type == 1) {
            const bf16_t* QM = WSP(bf16_t, WS_QM); const bf16_t* KVM = WSP(bf16_t, WS_KVM);
            att::attn_pass<192, 0>((LAS char*)lds, QM + qrow * 768 + h * 192, 768, KVM + brow * 1024 + h * 256, 1024, P + brow * NIN + PC_KR, NIN, KVM + brow * 1024 + h * 256 + 128, 1024,
                                   nullptr, 0.f, NT, qlo, 0.07216878364870322f * LOG2E, o);
            att::store_o(o, MIX + qrow * DM + 512 + h * 128, DM, r32, hi);
        } else
#endif
#ifndef SK_DIFF
        {
            unsigned o1p[4][8];
            att::attn_pass<64, 0>((LAS char*)lds, P + qrow * NIN + PC_DQ + h * 128, NIN, P + brow * NIN + PC_DK + h * 128, NIN, nullptr, 0, P + brow * NIN + PC_DV + h * 128, NIN,
                                  nullptr, 0.f, NT, qlo, 0.125f * LOG2E, o);
#pragma unroll
            for (int d = 0; d < 4; ++d)
#pragma unroll
                for (int r = 0; r < 8; ++r) o1p[d][r] = cvtpk(o[d][2 * r], o[d][2 * r + 1]);
            att::attn_pass<64, 0>((LAS char*)lds, P + qrow * NIN + PC_DQ + h * 128 + 64, NIN, P + brow * NIN + PC_DK + h * 128 + 64, NIN, nullptr, 0, P + brow * NIN + PC_DV + h * 128, NIN,
                                  nullptr, 0.f, NT, qlo, 0.125f * LOG2E, o);
            const float* g_diff = INP(float, 18);
            float gd[4];
#pragma unroll
            for (int d = 0; d < 4; ++d) gd[d] = g_diff[l * 128 + d * 32 + r32] * (1.0f - lam_init);
#pragma unroll
            for (int r = 0; r < 16; ++r) { float ss = 0.f;
#pragma unroll
                for (int d = 0; d < 4; ++d) { const unsigned pw = o1p[d][r >> 1]; const float o1v = __uint_as_float((r & 1) ? (pw & 0xffff0000u) : (pw << 16)); const float v = o1v - lam * o[d][r]; o[d][r] = v; ss += v * v; }
                ss += __shfl_xor(ss, 1); ss += __shfl_xor(ss, 2); ss += __shfl_xor(ss, 4); ss += __shfl_xor(ss, 8); ss += __shfl_xor(ss, 16);
                const float rs = 1.0f / sqrtf(ss * (1.0f / 128.0f) + EPSN);
#pragma unroll
                for (int d = 0; d < 4; ++d) o[d][r] *= rs * gd[d]; }
            att::store_o(o, MIX + qrow * DM + 1536 + h * 128, DM, r32, hi);
        }
#else
        {}
#endif
    }
}

__device__ __forceinline__ void ph_cross(const Args& a, char* lds, int l) {
    PH_IDS(); unsigned char* ws = launder(a.ws);
    const bf16_t* QC = WSP(bf16_t, WS_QC); const bf16_t* KVC = WSP(bf16_t, WS_KVC); bf16_t* OC = WSP(bf16_t, WS_OC);
    for (int u = blockIdx.x; u < 256; u += G) {
        const int qb = u & 7, bh = u >> 3, b = bh >> 2, h = bh & 3; const size_t qrow = (size_t)b * SEQ + qb * 256 + wave * 32;
        f32x16 o[4];
        att::attn_pass<128, 2>((LAS char*)lds, QC + qrow * 512 + h * 128, 512, KVC + (size_t)b * MEMLEN * 4096 + l * 1024 + h * 128, 4096, nullptr, 0,
                               KVC + (size_t)b * MEMLEN * 4096 + l * 1024 + 512 + h * 128, 4096, nullptr, 0.f, 4, 0, 0.08838834764831845f * LOG2E, o);
        att::store_o(o, OC + qrow * 512 + h * 128, 512, r32, hi);
    }
}
__device__ __forceinline__ void ph_norm(const Args& a, const float* x, int gidx, int l) {
    PH_IDS(); unsigned char* ws = launder(a.ws);
    rms_rows_bf16(x, INP(float, gidx) + (size_t)l * DM, WSP(bf16_t, WS_XN), MTOK, gw, ngw, lane);
}
__device__ __forceinline__ void ph_final(const Args& a) {
    PH_IDS(); float* outp = launder(a.out); const float* g_final = INP(float, 30); unsigned char* ws = launder(a.ws); const bf16_t* XB = WSP(bf16_t, WS_XN);
    for (int m = gw; m < MTOK; m += ngw) {
        const GAS u32x2* xr = (const GAS u32x2*)(XB + (size_t)m * DM) + lane; f32x4 v[8]; float s = 0.f;
#pragma unroll
        for (int j = 0; j < 8; ++j) { const u32x2 p = xr[64 * j]; v[j] = (f32x4){__uint_as_float(p.x << 16), __uint_as_float(p.x & 0xffff0000u), __uint_as_float(p.y << 16), __uint_as_float(p.y & 0xffff0000u)};
            s += (v[j].x * v[j].x + v[j].y * v[j].y) + (v[j].z * v[j].z + v[j].w * v[j].w); }
        const float rstd = 1.0f / sqrtf(wave_sum(s) * (1.0f / DM) + EPSN);
        GAS f32x4* o = (GAS f32x4*)(outp + (size_t)m * DM) + lane;
#pragma unroll
        for (int j = 0; j < 8; ++j) { const f32x4 gj = ((const f32x4*)g_final)[lane + 64 * j]; __builtin_nontemporal_store(v[j] * rstd * gj, o + 64 * j); }
    }
}

__global__ void __launch_bounds__(512, 2) fwd_kernel(Args a) {
    extern __shared__ __attribute__((aligned(16))) unsigned char lds_raw[];
    cg::grid_group grid = cg::this_grid();
    const int G = gridDim.x;
    LAS unsigned char* ldsL = (LAS unsigned char*)lds_raw;
    char* lds = (char*)lds_raw;
    { volatile LAS unsigned* z = (volatile LAS unsigned*)(ldsL + LDSCTL_OFF); if (threadIdx.x < 64) z[threadIdx.x] = 0u; }
    __syncthreads();
    (void)xcd_barrier_post((unsigned*)(launder(a.ws) + WS_CTL) + 4096, (volatile LAS unsigned*)(ldsL + LDSCTL_OFF) + 8);
#define GRID_BAR() do { XcdBarrier bar_; bar_.bar = (unsigned*)(launder(a.ws) + WS_CTL) + 4096; bar_.x = xb_xcc_id(); bar_.st = (volatile LAS unsigned*)(launder(ldsL) + LDSCTL_OFF) + 8; xcd_barrier(bar_); } while (0)
#ifndef SK_P0
    ph_prologue(a, lds);
#endif
    if (gridDim.y == 0x7fffu) grid.sync();
    GRID_BAR();
    for (int rep = 0; rep < DUP_PRO; ++rep) { ph_prologue(a, lds); GRID_BAR(); }
    for (int l = 0; l < DEPTH; ++l) {
        for (int rep = 0; rep <= DUP_G; ++rep) {
        { unsigned char* ws = launder(a.ws); unsigned char* lw = ws + WS_LW + (size_t)l * LW_STRIDE;
          EpiBf16G E{WSP(bf16_t, WS_P), NIN, WSP(float, WS_RS) + (size_t)(3 * l) * MTOK * 8, 1.0f / DM, 1, 1, WSP(float, WS_COSM), WSP(float, WS_SINM), WSP(float, WS_COSD), WSP(float, WS_SIND), WSP(float, WS_FF)};
          run_gemm(ldsL, WSP(bf16_t, WS_XN), DM, (const bf16_t*)(lw + LW_WIN), DM, MTOK, NIN, DM, E); }
        if (rep < DUP_G) GRID_BAR(); }
        GRID_BAR();
#ifndef SK_P3
        ph_misc(a, lds, l);
#endif
        for (int rep = 0; rep <= DUP_G; ++rep) {
        { unsigned char* ws = launder(a.ws); unsigned char* lw = ws + WS_LW + (size_t)l * LW_STRIDE;
          EpiLat<12, true> E{WSP(bf16_t, WS_QM), 768, WSP(float, WS_RSQ), 1.0f / 384.0f, WSP(float, WS_COSM), WSP(float, WS_SINM)};
          run_gemm(ldsL, WSP(bf16_t, WS_P) + PC_CQ, NIN, (const bf16_t*)(lw + LW_UQ), 384, MTOK, 768, 384, E); }
        { unsigned char* ws = launder(a.ws); unsigned char* lw = ws + WS_LW + (size_t)l * LW_STRIDE;
          EpiLat<8, false> E{WSP(bf16_t, WS_KVM), 1024, WSP(float, WS_RSKV), 1.0f / 256.0f, nullptr, nullptr};
          run_gemm(ldsL, WSP(bf16_t, WS_P) + PC_CKV, NIN, (const bf16_t*)(lw + LW_UKV), 256, MTOK, 1024, 256, E); }
        if (rep < DUP_G) GRID_BAR(); }
        GRID_BAR();
        ph_attn(a, lds, l, 0);
        GRID_BAR();
        for (int rep = 1; rep <= DUP_ATT; ++rep) { ph_attn(a, lds, l, rep); GRID_BAR(); }
        for (int e = 0; e < EXTRA_SYNC; ++e) GRID_BAR();
        { unsigned char* ws = launder(a.ws); unsigned char* lw = ws + WS_LW + (size_t)l * LW_STRIDE;
          EpiRes E{WSP(bf16_t, WS_XN), DM, WSP(float, WS_RS) + (size_t)(3 * l + 1) * MTOK * 8, (LAS float*)(ldsL + LDSP_OFF)}; run_gemm(ldsL, WSP(bf16_t, WS_MIX), DM, (const bf16_t*)(lw + LW_WO), DM, MTOK, DM, DM, E); }
        GRID_BAR();
        for (int rep = 0; rep <= DUP_G; ++rep) {
        { unsigned char* ws = launder(a.ws); unsigned char* lw = ws + WS_LW + (size_t)l * LW_STRIDE;
          EpiBf16G E{WSP(bf16_t, WS_QC), 512, WSP(float, WS_RS) + (size_t)(3 * l + 1) * MTOK * 8, 1.0f / DM, 0, 1, nullptr, nullptr, nullptr, nullptr, nullptr}; if (l == 0 && G >= 256 && blockIdx.x >= 128) {
              EpiBf16G E2{WSP(bf16_t, WS_KVC), 4096, nullptr, 0.f, 0, 0, nullptr, nullptr, nullptr, nullptr, nullptr};
              pg8::Gemm g2{WSP(bf16_t, WS_MEMN), WSP(bf16_t, WS_KVCW), MEMROWS, 4096, DM, DM, DM}; pg8::StaticOrder S2; S2.init(MEMROWS, 4096, 128, (int)blockIdx.x - 128);
              pg8::gemm_phase<EpiBf16G, pg8::StaticOrder>(ldsL, g2, S2, E2);
          } else if (l == 0 && G < 256) {
              EpiBf16G E2{WSP(bf16_t, WS_KVC), 4096, nullptr, 0.f, 0, 0, nullptr, nullptr, nullptr, nullptr, nullptr};
              run_gemm(ldsL, WSP(bf16_t, WS_MEMN), DM, WSP(bf16_t, WS_KVCW), DM, MEMROWS, 4096, DM, E2); run_gemm(ldsL, WSP(bf16_t, WS_XN), DM, (const bf16_t*)(lw + LW_CQ), DM, MTOK, 512, DM, E);
          } else run_gemm(ldsL, WSP(bf16_t, WS_XN), DM, (const bf16_t*)(lw + LW_CQ), DM, MTOK, 512, DM, E); }
        if (rep < DUP_G) GRID_BAR(); }
        GRID_BAR();
#ifndef SK_P9
        ph_cross(a, lds, l);
        for (int rep = 0; rep < DUP_P9; ++rep) { GRID_BAR(); ph_cross(a, lds, l); }
#endif
        GRID_BAR();
        { unsigned char* ws = launder(a.ws); unsigned char* lw = ws + WS_LW + (size_t)l * LW_STRIDE;
          EpiRes E{WSP(bf16_t, WS_XN), DM, WSP(float, WS_RS) + (size_t)(3 * l + 2) * MTOK * 8, (LAS float*)(ldsL + LDSP_OFF)}; run_gemm(ldsL, WSP(bf16_t, WS_OC), 512, (const bf16_t*)(lw + LW_CO), 512, MTOK, DM, 512, E); }
        GRID_BAR();
        for (int rep = 0; rep <= DUP_P12; ++rep) {
        { unsigned char* ws = launder(a.ws); unsigned char* lw = ws + WS_LW + (size_t)l * LW_STRIDE;
          EpiSwiglu E{WSP(bf16_t, WS_HID), FFH, WSP(float, WS_RS) + (size_t)(3 * l + 2) * MTOK * 8}; run_gemm(ldsL, WSP(bf16_t, WS_XN), DM, (const bf16_t*)(lw + LW_GU), DM, MTOK, 2 * FFH, DM, E); }
        if (rep < DUP_P12) GRID_BAR(); }
        GRID_BAR();
        { unsigned char* ws = launder(a.ws); unsigned char* lw = ws + WS_LW + (size_t)l * LW_STRIDE;
          EpiRes E{WSP(bf16_t, WS_XN), DM, WSP(float, WS_RS) + (size_t)(l + 1 < DEPTH ? 3 * l + 3 : 1) * MTOK * 8, (LAS float*)(ldsL + LDSP_OFF)}; run_gemm(ldsL, WSP(bf16_t, WS_HID), FFH, (const bf16_t*)(lw + LW_DN), FFH, MTOK, DM, FFH, E); }
        GRID_BAR();
    }
    ph_final(a);
}

extern "C" void kernel_launch(void* const* d_in, const int* in_sizes, int n_in, void* d_out, int out_size, void* d_ws, size_t ws_size, hipStream_t stream) {
    static int grid = 0;
    if (grid == 0) {
        if (n_in != 31 || out_size != MTOK * DM || ws_size < WS_END) { fprintf(stderr, "kernel_launch: unexpected shapes (n_in %d out %d ws %zu need %zu)\n", n_in, out_size, ws_size, (size_t)WS_END); grid = -1; return; }
        int dev = 0, cus = 0, per_cu = 0;
        (void)hipGetDevice(&dev);
        (void)hipDeviceGetAttribute(&cus, hipDeviceAttributeMultiprocessorCount, dev);
        (void)hipFuncSetAttribute((const void*)fwd_kernel, hipFuncAttributeMaxDynamicSharedMemorySize, LDS_BYTES);
        (void)hipOccupancyMaxActiveBlocksPerMultiprocessor(&per_cu, (const void*)fwd_kernel, 512, LDS_BYTES);
        if (per_cu < 1) { fprintf(stderr, "kernel_launch: occupancy query says %d blocks per CU\n", per_cu); per_cu = 1; }
        grid = cus > 0 ? cus : 256;
    }
    if (grid < 0) return;
    (void)hipMemsetAsync((char*)d_ws + WS_CTL, 0, 65536, stream);
    Args a{};
    for (int i = 0; i < 31; ++i) a.in[i] = d_in[i];
    a.out = (float*)d_out; a.ws = (unsigned char*)d_ws;
    void* args[] = {&a};
    hipError_t e = hipLaunchCooperativeKernel((const void*)fwd_kernel, dim3(grid), dim3(512), args, LDS_BYTES, stream);
    if (e != hipSuccess) fprintf(stderr, "cooperative launch failed: %s (grid %d)\n", hipGetErrorString(e), grid);
}
```

```cpp
#include <hip/hip_runtime.h>
#include <hip/hip_cooperative_groups.h>
#include <cstdio>
#include <cstdint>
namespace cg = cooperative_groups;

#define LAS __attribute__((address_space(3)))
#define GAS __attribute__((address_space(1)))
typedef unsigned short bf16_t;
typedef short bf16x8 __attribute__((ext_vector_type(8)));
typedef short s16x4 __attribute__((ext_vector_type(4)));
typedef float f32x4 __attribute__((ext_vector_type(4)));
typedef float f32x16 __attribute__((ext_vector_type(16)));
typedef unsigned u32x4 __attribute__((ext_vector_type(4)));
typedef unsigned u32x2 __attribute__((ext_vector_type(2)));

constexpr int DM = 2048, NB = 8, SEQ = 2048, DEPTH = 4, MTOK = NB * SEQ;
constexpr int NIN_SRC = 4804, NIN = 4864;
constexpr int FFH = 5632, MEMLEN = 256, MEMROWS = NB * MEMLEN;
constexpr int PC_FQ = 0, PC_FK = 512, PC_FV = 1024, PC_CQ = 1536, PC_CKV = 1920, PC_KR = 2176, PC_FF = 2240, PC_U = 2304, PC_V = 2816, PC_DQ = 3328, PC_DK = 3840, PC_DV = 4352;
constexpr float LOG2E = 1.4426950408889634f;
constexpr float EPSN = 1e-6f;

constexpr size_t al256(size_t x) { return (x + 255) & ~(size_t)255; }
constexpr size_t WS_CTL = 0, CTL_BYTES = 1u << 20;
constexpr size_t SZ_WIN = (size_t)NIN * DM * 2, SZ_UQ = 768 * 384 * 2, SZ_UKV = 1024 * 256 * 2, SZ_WS = 4 * 128 * 128 * 2, SZ_WO = (size_t)DM * DM * 2,
                 SZ_CQ = 512 * (size_t)DM * 2, SZ_CO = (size_t)DM * 512 * 2, SZ_GU = (size_t)2 * FFH * DM * 2, SZ_DN = (size_t)DM * FFH * 2;
constexpr size_t LW_WIN = 0, LW_UQ = LW_WIN + SZ_WIN, LW_UKV = LW_UQ + SZ_UQ, LW_WS = LW_UKV + SZ_UKV, LW_WO = LW_WS + SZ_WS, LW_CQ = LW_WO + SZ_WO,
                 LW_CO = LW_CQ + SZ_CQ, LW_GU = LW_CO + SZ_CO, LW_DN = LW_GU + SZ_GU, LW_STRIDE = LW_DN + SZ_DN;
constexpr size_t WS_LW = WS_CTL + CTL_BYTES;
constexpr size_t WS_KVCW = WS_LW + DEPTH * LW_STRIDE;
constexpr size_t WS_XN = WS_KVCW + (size_t)4096 * DM * 2;
constexpr size_t WS_P = WS_XN + (size_t)MTOK * DM * 2;
constexpr size_t WS_MIX = WS_P + (size_t)MTOK * NIN * 2;
constexpr size_t WS_HID = WS_P;
constexpr size_t WS_QM = WS_MIX + (size_t)MTOK * DM * 2;
constexpr size_t WS_KVM = WS_QM + (size_t)MTOK * 768 * 2;
constexpr size_t WS_QC = WS_KVM + (size_t)MTOK * 1024 * 2;
constexpr size_t WS_OC = WS_QC + (size_t)MTOK * 512 * 2;
constexpr size_t WS_KVC = WS_OC + (size_t)MTOK * 512 * 2;
constexpr size_t WS_MEMN = WS_KVC + (size_t)MEMROWS * 4096 * 2;
constexpr size_t WS_FF = WS_MEMN + (size_t)MEMROWS * DM * 2;
constexpr size_t WS_CUMF = WS_FF + (size_t)MTOK * 4 * 4;
constexpr size_t WS_RSQ = WS_CUMF + (size_t)32 * SEQ * 4;
constexpr size_t WS_RSKV = WS_RSQ + (size_t)MTOK * 12 * 4;
constexpr size_t WS_COSM = WS_RSKV + (size_t)MTOK * 8 * 4;
constexpr size_t WS_SINM = WS_COSM + (size_t)MTOK * 32 * 4;
constexpr size_t WS_COSD = WS_SINM + (size_t)MTOK * 32 * 4;
constexpr size_t WS_SIND = WS_COSD + (size_t)MTOK * 8 * 4;
constexpr size_t WS_RS = WS_SIND + (size_t)MTOK * 8 * 4;
constexpr size_t WS_END = WS_RS + (size_t)12 * MTOK * 8 * 4;
static_assert(WS_HID + (size_t)MTOK * FFH * 2 <= WS_QM, "HID overlay");
static_assert(LW_STRIDE % 256 == 0, "align");

constexpr int DUP_ATT = 0, DUP_PRO = 0, EXTRA_SYNC = 0, DUP_P12 = 0, DUP_P3 = 0, DUP_G = 0, DUP_P9 = 0;
constexpr int LDS_BYTES = 147456;
constexpr int LDSCTL_OFF = 131072;
constexpr int LDSP_OFF = 131072 + 1024;

__device__ __forceinline__ unsigned f2bf(float f) { unsigned u = __float_as_uint(f); return (u + 0x7fffu + ((u >> 16) & 1u)) >> 16; }
__device__ __forceinline__ unsigned pk2(float lo, float hi) { return f2bf(lo) | (f2bf(hi) << 16); }
__device__ __forceinline__ float bf2f(unsigned short h) { return __uint_as_float(((unsigned)h) << 16); }
__device__ __forceinline__ unsigned cvtpk(float lo, float hi) { unsigned r; asm volatile("v_cvt_pk_bf16_f32 %0, %1, %2" : "=v"(r) : "v"(lo), "v"(hi)); return r; }
__device__ __forceinline__ float wave_sum(float v) {
#pragma unroll
    for (int o = 1; o < 64; o <<= 1) v += __shfl_xor(v, o);
    return v;
}
__device__ __forceinline__ float gelu_tanh(float x) {
    const float y = 0.7978845608028654f * (x + 0.044715f * x * x * x);
    const float e = __builtin_amdgcn_exp2f(-2.0f * LOG2E * y);
    return x * __builtin_amdgcn_rcpf(1.0f + e);
}
__device__ __forceinline__ int opaque_tid() { int t = threadIdx.x; asm volatile("" : "+v"(t)); return t; }
template <class T> __device__ __forceinline__ T* launder(T* p) { asm volatile("" : "+s"(p)); return p; }
__device__ __forceinline__ int crow(int r, int hi) { return (r & 3) + 8 * (r >> 2) + 4 * hi; }

namespace pg8 {
constexpr int BM = 256, BK = 64, HALF = 128, HTB = HALF * BK * 2, STAGE_BYTES = 8 * HTB, NXCD = 8, WGM = 8;
__host__ __device__ __forceinline__ int lds_byte(int r, int c) { const int st = (r >> 4) * 2 + (c >> 5), rr = r & 15, cc = c & 31, ob = rr * 64 + cc * 2; return st * 1024 + (ob ^ (((ob >> 9) & 1) << 5)); }
__host__ __device__ __forceinline__ void stage_rc(int b, int& R, int& C) { const int st = b / 1024, sb = b % 1024, swz = sb ^ (((sb >> 9) & 1) << 5); R = (st >> 1) * 16 + swz / 64; C = (st & 1) * 32 + (swz % 64) / 2; }
__host__ __device__ __forceinline__ int perm32(int rho) { const int n = rho >> 4, i = rho & 15; return 8 * (i >> 2) + 4 * n + (i & 3); }
struct Unit { int pm, pn; };
struct Gemm { const bf16_t* A; const bf16_t* Bt; int M, N, K, lda, ldb; };
struct StaticOrder {
    int nM, nN, nwg, G, c;
    __device__ void init(int M, int N, int G_, int c_) { nM = M / BM; nN = N / BM; nwg = nM * nN; G = G_; c = c_; }
    __device__ bool next(int i, Unit& u) const {
        const long L = (long)i * G + c; if (L >= nwg) return false;
        int wgid = (int)L; { const int q = nwg / NXCD, r = nwg % NXCD, xcd = wgid % NXCD, off = wgid / NXCD; wgid = (xcd < r ? xcd * (q + 1) : r * (q + 1) + (xcd - r) * q) + off; }
        const int nig = WGM * nN, gid = wgid / nig, fm = gid * WGM, gsz = (nM - fm) < WGM ? (nM - fm) : WGM;
        u.pm = fm + ((wgid % nig) % gsz); u.pn = (wgid % nig) / gsz; return true;
    }
};
template <class Epi, class Sched>
__device__ __forceinline__ void gemm_phase(LAS unsigned char* lds, const Gemm g, const Sched& S, const Epi& E) {
    const int tid = opaque_tid(), wid = __builtin_amdgcn_readfirstlane(tid >> 6), lane = tid & 63, wr = wid >> 2, wc = wid & 3, fr = lane & 15, fq = lane >> 4;
    const int K = g.K, nt = K / BK;
    unsigned voffA[2], voffB[2];
#pragma unroll
    for (int i = 0; i < 2; ++i) { int R, C; stage_rc(tid * 16 + i * 8192, R, C); const int Rb = Epi::PERM ? ((R & ~31) + perm32(R & 31)) : R;
        voffA[i] = (unsigned)(R * g.lda + C) * 2u; voffB[i] = (unsigned)(Rb * g.ldb + C) * 2u; }
    const size_t kstep = (size_t)(BK * 2);
    const size_t hstepA = (size_t)HALF * g.lda * 2, hstepB = (size_t)HALF * g.ldb * 2;
    const size_t tstepA = 2 * hstepA, tstepB = 2 * hstepB;
    const unsigned ldsw = (unsigned)wid * 1024u;
    const int aoff = lds_byte(wr * 64 + fr, fq * 8), boff = lds_byte(wc * 32 + fr, fq * 8);
#define PG8_SA(b, h) (((b) * 2 + (h)) * HTB)
#define PG8_SB(b, h) ((4 + (b) * 2 + (h)) * HTB)
#define PG8_STAGE(bufoff, gbase, voff) do { _Pragma("unroll") for (int _i = 0; _i < 2; ++_i) \
        __builtin_amdgcn_global_load_lds((const unsigned*)((const char*)(gbase) + (voff)[_i]), (LAS unsigned*)(lds + (bufoff) + ldsw + _i * 8192), 16, 0, 0); } while (0)
#define PG8_LDA(dst, b, h) do { _Pragma("unroll") for (int m = 0; m < 4; ++m) _Pragma("unroll") for (int k = 0; k < 2; ++k) dst[m][k] = *(const LAS bf16x8*)(lds + PG8_SA(b, h) + aoff + m * 2048 + k * 1024); } while (0)
#define PG8_LDB(dst, b, h) do { _Pragma("unroll") for (int n = 0; n < 2; ++n) _Pragma("unroll") for (int k = 0; k < 2; ++k) dst[n][k] = *(const LAS bf16x8*)(lds + PG8_SB(b, h) + boff + n * 2048 + k * 1024); } while (0)
#define PG8_MMA(ai, bj, At, Bt) do { __builtin_amdgcn_s_setprio(1); _Pragma("unroll") for (int m = 0; m < 4; ++m) _Pragma("unroll") for (int n = 0; n < 2; ++n) _Pragma("unroll") for (int k = 0; k < 2; ++k) \
        acc[ai][bj][m][n] = __builtin_amdgcn_mfma_f32_16x16x32_bf16(Bt[n][k], At[m][k], acc[ai][bj][m][n], 0, 0, 0); __builtin_amdgcn_s_setprio(0); } while (0)
#define PG8_WAIT_V(n) asm volatile("s_waitcnt vmcnt(" #n ")" ::: "memory")
#define PG8_WAIT_L(n) asm volatile("s_waitcnt lgkmcnt(" #n ")" ::: "memory")
#define PG8_BAR __builtin_amdgcn_s_barrier()
#define PG8_SCHED __builtin_amdgcn_sched_barrier(0)
    Unit cur, nxt; int ui = 0;
    if (!S.next(0, cur)) return;
    constexpr bool SC = Epi::SC8;
    LAS float* scb = (LAS float*)(lds + 139264);
    f32x4 pqa = (f32x4){0.f, 0.f, 0.f, 0.f}, pqb = (f32x4){0.f, 0.f, 0.f, 0.f};
#define PG8_SC_ISSUE(U) do { if (SC && tid < 256 && E.sc_rowsq()) { const float* rp_ = E.sc_rowsq() + (size_t)((U).pm * 256 + tid) * 8; pqa = *(const GAS f32x4*)rp_; pqb = *(const GAS f32x4*)(rp_ + 4); } } while (0)
#define PG8_SC_COMMIT(b_) do { if (SC && tid < 256) { float v_ = 1.f; if (E.sc_rowsq()) v_ = __builtin_amdgcn_rsqf((((pqa.x + pqa.y) + (pqa.z + pqa.w)) + ((pqb.x + pqb.y) + (pqb.z + pqb.w))) * E.sc_inv_n() + EPSN); scb[(b_) * 256 + tid] = v_; } } while (0)
    PG8_SC_ISSUE(cur); PG8_SC_COMMIT(0);
    f32x4 acc[2][2][4][2];
#pragma unroll
    for (int a = 0; a < 2; ++a)
#pragma unroll
        for (int b = 0; b < 2; ++b)
#pragma unroll
            for (int m = 0; m < 4; ++m)
#pragma unroll
                for (int n = 0; n < 2; ++n) acc[a][b][m][n] = (f32x4){0.f, 0.f, 0.f, 0.f};
    bf16x8 At[4][2], B0[2][2], B1[2][2];
    const char* cA = (const char*)g.A + (size_t)cur.pm * tstepA; const char* cB = (const char*)g.Bt + (size_t)cur.pn * tstepB;
    PG8_STAGE(PG8_SB(0, 0), cB, voffB); PG8_STAGE(PG8_SB(0, 1), cB + hstepB, voffB); PG8_STAGE(PG8_SA(0, 0), cA, voffA); PG8_STAGE(PG8_SA(0, 1), cA + hstepA, voffA);
    if (wr == 1) PG8_BAR;
    PG8_WAIT_V(2); PG8_BAR;
    PG8_STAGE(PG8_SB(1, 0), cB + kstep, voffB); PG8_STAGE(PG8_SA(1, 0), cA + kstep, voffA); PG8_STAGE(PG8_SB(1, 1), cB + hstepB + kstep, voffB);
    PG8_WAIT_V(6); PG8_BAR;
    for (;;) {
        const bool has_next = S.next(ui + 1, nxt);
        const char* nA = has_next ? (const char*)g.A + (size_t)nxt.pm * tstepA : cA; const char* nB = has_next ? (const char*)g.Bt + (size_t)nxt.pn * tstepB : cB;
        for (int t = 0; t < nt; t += 2) {
            const bool last = (t == nt - 2);
            const char* a1 = cA + (size_t)(t + 1) * kstep;
            const char* a2 = last ? nA : cA + (size_t)(t + 2) * kstep; const char* b2 = last ? nB : cB + (size_t)(t + 2) * kstep;
            const char* a3 = a2 + kstep; const char* b3 = b2 + kstep;
            PG8_LDB(B0, 0, 0); PG8_LDB(B1, 0, 1); PG8_SCHED; PG8_LDA(At, 0, 0); PG8_STAGE(PG8_SA(1, 1), a1 + hstepA, voffA);
            PG8_WAIT_V(8); PG8_WAIT_L(0); PG8_BAR; PG8_MMA(0, 0, At, B0); PG8_MMA(0, 1, At, B1); PG8_BAR; PG8_SCHED;
            PG8_LDA(At, 0, 1); PG8_STAGE(PG8_SB(0, 0), b2, voffB); PG8_STAGE(PG8_SB(0, 1), b2 + hstepB, voffB); PG8_STAGE(PG8_SA(0, 0), a2, voffA);
            PG8_WAIT_V(8); PG8_WAIT_L(0); PG8_BAR; PG8_MMA(1, 0, At, B0); PG8_MMA(1, 1, At, B1); PG8_BAR; PG8_SCHED;
            PG8_LDB(B0, 1, 0); PG8_LDB(B1, 1, 1); PG8_SCHED; PG8_LDA(At, 1, 0); PG8_STAGE(PG8_SA(0, 1), a2 + hstepA, voffA);
            PG8_WAIT_V(8); PG8_WAIT_L(0); PG8_BAR; PG8_MMA(0, 0, At, B0); PG8_MMA(0, 1, At, B1); PG8_BAR; PG8_SCHED;
            PG8_LDA(At, 1, 1); PG8_STAGE(PG8_SB(1, 0), b3, voffB); PG8_STAGE(PG8_SB(1, 1), b3 + hstepB, voffB); PG8_STAGE(PG8_SA(1, 0), a3, voffA);
            PG8_WAIT_V(8); PG8_WAIT_L(0); PG8_BAR; PG8_MMA(1, 0, At, B0); PG8_MMA(1, 1, At, B1); PG8_BAR; PG8_SCHED;
        }
        if (wr == 0) PG8_BAR;
        if (has_next) PG8_SC_ISSUE(nxt);
        { const int l2 = opaque_tid() & 63; E(acc, cur, wr, wc, l2 & 15, l2 >> 4, (const LAS float*)(scb + (ui & 1) * 256)); }
        if (has_next) PG8_SC_COMMIT((ui + 1) & 1);
        if (!has_next) break;
#pragma unroll
        for (int a = 0; a < 2; ++a)
#pragma unroll
            for (int b = 0; b < 2; ++b)
#pragma unroll
                for (int m = 0; m < 4; ++m)
#pragma unroll
                    for (int n = 0; n < 2; ++n) acc[a][b][m][n] = (f32x4){0.f, 0.f, 0.f, 0.f};
        cur = nxt; cA = nA; cB = nB; ++ui;
        if (wr == 1) PG8_BAR;
    }
    PG8_WAIT_V(0);
    PG8_BAR;
#undef PG8_SC_ISSUE
#undef PG8_SC_COMMIT
#undef PG8_SA
#undef PG8_SB
#undef PG8_STAGE
#undef PG8_LDA
#undef PG8_LDB
#undef PG8_MMA
#undef PG8_WAIT_V
#undef PG8_WAIT_L
#undef PG8_BAR
#undef PG8_SCHED
}
}

struct EpiBf16G {
    static constexpr bool PERM = true, SC8 = true;
    __device__ __forceinline__ const float* sc_rowsq() const { return rowsq; }
    __device__ __forceinline__ float sc_inv_n() const { return inv_n; }
    bf16_t* O; int ldc; const float* rowsq; float inv_n; int mode; int p8;
    const float* cosM; const float* sinM; const float* cosD; const float* sinD; float* ff;
    __device__ __forceinline__ void operator()(const f32x4 (&acc)[2][2][4][2], const pg8::Unit& u, int wr, int wc, int fr, int fq, const LAS float* scr) const {
        const int row0 = u.pm * 256 + wr * 64 + fr;
#pragma unroll
        for (int bj = 0; bj < 2; ++bj) {
            const int c0 = u.pn * 256 + bj * 128 + wc * 32, col0 = c0 + 8 * fq;
            int kind = 0, j0 = 0; bool ffw = false;
            if (mode == 1) {
                if (c0 >= PC_KR && c0 < PC_KR + 64) { kind = 1; j0 = ((c0 - PC_KR) >> 1) + 4 * fq; }
                else if (c0 >= PC_DQ && c0 < PC_DV && (c0 & 63) == 0 && fq < 2) { kind = 2; j0 = 4 * fq; }
                ffw = (c0 == PC_FF) && (fq == 0);
            } else if (mode == 2) {
                if (((c0 & ~63) % 192) == 128) { kind = 1; j0 = ((c0 & 32) ? 16 : 0) + 4 * fq; }
            }
#pragma unroll
            for (int ai = 0; ai < 2; ++ai)
#pragma unroll
                for (int m = 0; m < 4; ++m) {
                    const int row = row0 + ai * 128 + m * 16;
                    const float sc_ = scr[ai * 128 + wr * 64 + m * 16 + fr]; f32x4 v0 = acc[ai][bj][m][0] * sc_, v1 = acc[ai][bj][m][1] * sc_;
                    if (kind == 1) { const f32x4 c = *(const GAS f32x4*)(cosM + (size_t)row * 32 + j0), s = *(const GAS f32x4*)(sinM + (size_t)row * 32 + j0);
                        const f32x4 a = v0 * c - v1 * s, b = v0 * s + v1 * c; v0 = a; v1 = b; }
                    else if (kind == 2) { const f32x4 c = *(const GAS f32x4*)(cosD + (size_t)row * 8 + j0), s = *(const GAS f32x4*)(sinD + (size_t)row * 8 + j0);
                        const f32x4 a = v0 * c - v1 * s, b = v0 * s + v1 * c; v0 = a; v1 = b; }
                    if (ffw) *(GAS f32x4*)(ff + (size_t)row * 4) = v0;
                    if (mode == 1 && c0 >= PC_CQ && c0 < PC_KR) {
                        float ss = ((v0.x * v0.x + v0.y * v0.y) + (v0.z * v0.z + v0.w * v0.w)) + ((v1.x * v1.x + v1.y * v1.y) + (v1.z * v1.z + v1.w * v1.w));
                        ss += __shfl_xor(ss, 16); ss += __shfl_xor(ss, 32);
                        float* lsq = ff + (WS_RSQ - WS_FF) / 4; float* lskv = ff + (WS_RSKV - WS_FF) / 4;
                        if (fq == 0) { if (c0 < PC_CKV) *(GAS float*)(lsq + (size_t)row * 12 + ((c0 - PC_CQ) >> 5)) = ss; else *(GAS float*)(lskv + (size_t)row * 8 + ((c0 - PC_CKV) >> 5)) = ss; } }
                    u32x4 w; w.x = cvtpk(v0[0], v0[1]); w.y = cvtpk(v0[2], v0[3]); w.z = cvtpk(v1[0], v1[1]); w.w = cvtpk(v1[2], v1[3]);
                    *(GAS u32x4*)(O + (size_t)row * ldc + col0) = w;
                    if ((m & 1) || kind) asm volatile("" ::: "memory");
                }
        }
    }
};
template <int NP, bool ROPE> struct EpiLat {
    static constexpr bool PERM = true, SC8 = false;
    __device__ __forceinline__ const float* sc_rowsq() const { return nullptr; }
    __device__ __forceinline__ float sc_inv_n() const { return 0.f; }
    bf16_t* O; int ldc; const float* part; float inv_n; const float* cosM; const float* sinM;
    __device__ __forceinline__ void operator()(const f32x4 (&acc)[2][2][4][2], const pg8::Unit& u, int wr, int wc, int fr, int fq, const LAS float* scr) const {
        const int row0 = u.pm * 256 + wr * 64 + fr;
#pragma unroll
        for (int ai = 0; ai < 2; ++ai)
#pragma unroll
            for (int m = 0; m < 4; ++m) { const int row = row0 + ai * 128 + m * 16; const float* rp = part + (size_t)row * NP; float q = 0.f;
#pragma unroll
                for (int j = 0; j < NP / 4; ++j) { const f32x4 t = *(const GAS f32x4*)(rp + 4 * j); q += (t.x + t.y) + (t.z + t.w); }
                const float sc = __builtin_amdgcn_rsqf(q * inv_n + EPSN);
#pragma unroll
                for (int bj = 0; bj < 2; ++bj) { const int c0 = u.pn * 256 + bj * 128 + wc * 32, col0 = c0 + 8 * fq;
                    f32x4 v0 = acc[ai][bj][m][0] * sc, v1 = acc[ai][bj][m][1] * sc;
                    if (ROPE && ((c0 & ~63) % 192) == 128) { const int j0 = ((c0 & 32) ? 16 : 0) + 4 * fq;
                        const f32x4 c = *(const GAS f32x4*)(cosM + (size_t)row * 32 + j0), s = *(const GAS f32x4*)(sinM + (size_t)row * 32 + j0);
                        const f32x4 a = v0 * c - v1 * s, b = v0 * s + v1 * c; v0 = a; v1 = b; }
                    u32x4 w; w.x = cvtpk(v0[0], v0[1]); w.y = cvtpk(v0[2], v0[3]); w.z = cvtpk(v1[0], v1[1]); w.w = cvtpk(v1[2], v1[3]);
                    *(GAS u32x4*)(O + (size_t)row * ldc + col0) = w; }
                if (m & 1) asm volatile("" ::: "memory"); }
    }
};
struct EpiRes {
    static constexpr bool PERM = true, SC8 = false;
    __device__ __forceinline__ const float* sc_rowsq() const { return nullptr; }
    __device__ __forceinline__ float sc_inv_n() const { return 0.f; }
    bf16_t* xb; int ldc; float* rsp; LAS float* ldsp;
    __device__ __forceinline__ void operator()(const f32x4 (&acc)[2][2][4][2], const pg8::Unit& u, int wr, int wc, int fr, int fq, const LAS float* scr) const {
        const int row0 = u.pm * 256 + wr * 64 + fr, col0 = u.pn * 256 + wc * 32 + 8 * fq;
        u32x4 pre[2][4][2];
#pragma unroll
        for (int ai = 0; ai < 2; ++ai)
#pragma unroll
            for (int m = 0; m < 4; ++m)
#pragma unroll
                for (int bj = 0; bj < 2; ++bj) pre[ai][m][bj] = *(const GAS u32x4*)(xb + (size_t)(row0 + ai * 128 + m * 16) * ldc + col0 + bj * 128);
#pragma unroll
        for (int ai = 0; ai < 2; ++ai)
#pragma unroll
            for (int m = 0; m < 4; ++m) { float ss = 0.f;
#pragma unroll
                for (int bj = 0; bj < 2; ++bj) { const u32x4 p = pre[ai][m][bj]; const f32x4 a0 = acc[ai][bj][m][0], a1 = acc[ai][bj][m][1];
                    const float v0 = __uint_as_float(p.x << 16) + a0.x, v1 = __uint_as_float(p.x & 0xffff0000u) + a0.y, v2 = __uint_as_float(p.y << 16) + a0.z, v3 = __uint_as_float(p.y & 0xffff0000u) + a0.w;
                    const float v4 = __uint_as_float(p.z << 16) + a1.x, v5 = __uint_as_float(p.z & 0xffff0000u) + a1.y, v6 = __uint_as_float(p.w << 16) + a1.z, v7 = __uint_as_float(p.w & 0xffff0000u) + a1.w;
                    ss += ((v0 * v0 + v1 * v1) + (v2 * v2 + v3 * v3)) + ((v4 * v4 + v5 * v5) + (v6 * v6 + v7 * v7));
                    u32x4 w; w.x = cvtpk(v0, v1); w.y = cvtpk(v2, v3); w.z = cvtpk(v4, v5); w.w = cvtpk(v6, v7);
                    *(GAS u32x4*)(xb + (size_t)(row0 + ai * 128 + m * 16) * ldc + col0 + bj * 128) = w; }
                ss += __shfl_xor(ss, 16); ss += __shfl_xor(ss, 32);
                if (fq == 0) ldsp[(ai * 128 + wr * 64 + m * 16 + fr) * 4 + wc] = ss; }
        asm volatile("s_waitcnt lgkmcnt(0)" ::: "memory"); __builtin_amdgcn_s_barrier(); asm volatile("" ::: "memory");
        const int t = (wr * 4 + wc) * 64 + fq * 16 + fr;
        if (t < 256) { const f32x4 p = *(const LAS f32x4*)(ldsp + t * 4); *(GAS float*)(rsp + (size_t)(u.pm * 256 + t) * 8 + u.pn) = (p.x + p.y) + (p.z + p.w); }
        asm volatile("s_waitcnt lgkmcnt(0)" ::: "memory"); __builtin_amdgcn_s_barrier(); asm volatile("" ::: "memory");
    }
};
struct EpiSwiglu {
    static constexpr bool PERM = true, SC8 = true;
    __device__ __forceinline__ const float* sc_rowsq() const { return rowsq; }
    __device__ __forceinline__ float sc_inv_n() const { return 1.0f / DM; }
    bf16_t* H; int ldc; const float* rowsq;
    __device__ __forceinline__ void operator()(const f32x4 (&acc)[2][2][4][2], const pg8::Unit& u, int wr, int wc, int fr, int fq, const LAS float* scr) const {
        const int row0 = u.pm * 256 + wr * 64 + fr, col0 = u.pn * 128 + wc * 32 + 8 * fq;
#pragma unroll
        for (int ai = 0; ai < 2; ++ai)
#pragma unroll
            for (int m = 0; m < 4; ++m) { const int row = row0 + ai * 128 + m * 16; float r[8]; const float s_ = scr[ai * 128 + wr * 64 + m * 16 + fr];
                const float k_ = -LOG2E * s_, s2_ = s_ * s_;
#pragma unroll
                for (int n = 0; n < 2; ++n)
#pragma unroll
                    for (int i = 0; i < 4; ++i) { const float g_ = acc[ai][0][m][n][i], u_ = acc[ai][1][m][n][i];
                        r[n * 4 + i] = (g_ * u_) * (s2_ * __builtin_amdgcn_rcpf(1.0f + __builtin_amdgcn_exp2f(g_ * k_))); }
                typedef float f32x2_ __attribute__((ext_vector_type(2))); typedef __bf16 bf16x2_ __attribute__((ext_vector_type(2)));
                u32x4 w;
                { const f32x2_ a0 = {r[0], r[1]}, a1 = {r[2], r[3]}, a2 = {r[4], r[5]}, a3 = {r[6], r[7]};
                  w.x = __builtin_bit_cast(unsigned, __builtin_convertvector(a0, bf16x2_)); w.y = __builtin_bit_cast(unsigned, __builtin_convertvector(a1, bf16x2_));
                  w.z = __builtin_bit_cast(unsigned, __builtin_convertvector(a2, bf16x2_)); w.w = __builtin_bit_cast(unsigned, __builtin_convertvector(a3, bf16x2_)); }
                *(GAS u32x4*)(H + (size_t)row * ldc + col0) = w; }
    }
};
template <class Epi> __device__ __forceinline__ void run_gemm(LAS unsigned char* lds, const bf16_t* A, int lda, const bf16_t* Bt, int ldb, int M, int N, int K, const Epi& E) {
    pg8::Gemm g{A, Bt, M, N, K, lda, ldb}; pg8::StaticOrder S; S.init(M, N, (int)gridDim.x, (int)blockIdx.x);
    pg8::gemm_phase<Epi, pg8::StaticOrder>(lds, g, S, E);
}

namespace att {
constexpr int SHM_V = 64 * 128 * 2, SHM_KMAX = 64 * 192 * 2;
constexpr int OFF_K = 2 * SHM_V, OFF_FK = OFF_K + 2 * SHM_KMAX, OFF_WS = OFF_FK + 512, ATT_LDS = OFF_WS + 8 * 64 * 4;
#define SBAR() __builtin_amdgcn_sched_barrier(0)
__device__ __forceinline__ int v_st(int k, int c) { const int kk = (k & ~0xC) | ((k & 4) << 1) | ((k & 8) >> 1); return ((kk >> 3) * 4 + (c >> 5)) * 512 + ((kk & 7) * 32 + (c & 31)) * 2; }
__device__ __forceinline__ int v_rd_base(int lane) { return ((lane & 3) << 3) | (((lane >> 2) & 3) << 6) | (((lane >> 4) & 1) << 5) | (((lane >> 5) & 1) << 8); }
constexpr int v_rd_off(int d0, int ks, int half) { return d0 * 512 + ks * 4096 + half * 2048; }

__device__ __forceinline__ void pv_tile(f32x16* o, int vb0, bf16x8 pa0, bf16x8 pa1, bf16x8 pa2, bf16x8 pa3) {
#define TRRD(dst, off) asm volatile("ds_read_b64_tr_b16 %0, %1 offset:%2" : "=&v"(dst) : "v"(vb0), "i"(off) : "memory")
#define RD8(L, H, ks) do { TRRD(L[0], v_rd_off(0, ks, 0)); TRRD(H[0], v_rd_off(0, ks, 1)); TRRD(L[1], v_rd_off(1, ks, 0)); TRRD(H[1], v_rd_off(1, ks, 1)); \
                           TRRD(L[2], v_rd_off(2, ks, 0)); TRRD(H[2], v_rd_off(2, ks, 1)); TRRD(L[3], v_rd_off(3, ks, 0)); TRRD(H[3], v_rd_off(3, ks, 1)); } while (0)
#define MM4(PA, L, H) do { _Pragma("unroll") for (int d0 = 0; d0 < 4; ++d0) \
        o[d0] = __builtin_amdgcn_mfma_f32_32x32x16_bf16(PA, (bf16x8){L[d0][0], L[d0][1], L[d0][2], L[d0][3], H[d0][0], H[d0][1], H[d0][2], H[d0][3]}, o[d0], 0, 0, 0); } while (0)
    s16x4 la[4], ha[4], lb[4], hb[4];
    RD8(la, ha, 0);
    RD8(lb, hb, 1); asm volatile("s_waitcnt lgkmcnt(8)" ::: "memory"); SBAR(); MM4(pa0, la, ha); SBAR();
    RD8(la, ha, 2); asm volatile("s_waitcnt lgkmcnt(8)" ::: "memory"); SBAR(); MM4(pa1, lb, hb); SBAR();
    RD8(lb, hb, 3); asm volatile("s_waitcnt lgkmcnt(8)" ::: "memory"); SBAR(); MM4(pa2, la, ha); SBAR();
    asm volatile("s_waitcnt lgkmcnt(0)" ::: "memory"); SBAR(); MM4(pa3, lb, hb);
#undef MM4
#undef RD8
#undef TRRD
}

template <int DK, int MODE>
__device__ __forceinline__ void attn_pass(LAS char* lds, const bf16_t* Qw, int qpitch, const bf16_t* Kb, int kpitch, const bf16_t* Kb2, int k2pitch,
                                          const bf16_t* Vb, int vpitch, const float* Fk, float Fq, int NT, int qlo, float C2, f32x16 (&o)[4]) {
    const int tid = opaque_tid(), wid = __builtin_amdgcn_readfirstlane(tid >> 6), lane = tid & 63, r32 = lane & 31, hi = lane >> 5;
    constexpr int PITCH = DK * 2, CPR = DK / 8, NKC = (64 * CPR) / 512, SHM_K = 64 * PITCH, ND = DK / 16;
    LAS char* V_lds = lds; LAS char* K_lds = lds + OFF_K; LAS float* fk_l = (LAS float*)(lds + OFF_FK); LAS float* ws = (LAS float*)(lds + OFF_WS) + wid * 64;
    bf16x8 qr[ND];
#pragma unroll
    for (int d0 = 0; d0 < ND; ++d0) qr[d0] = *(const GAS bf16x8*)(Qw + (size_t)r32 * qpitch + d0 * 16 + hi * 8);
    constexpr int NKI = (64 * PITCH) / 8192;
    const GAS bf16_t* kp[NKI]; int kstep[NKI];
#pragma unroll
    for (int i = 0; i < NKI; ++i) { const int off = (wid * NKI + i) * 1024 + lane * 16, row = off / PITCH, rem = off % PITCH, p = rem >> 4, ch = (p & ~7) | ((p & 7) ^ (row & 7));
        if (DK <= 128 || ch < 16) { kp[i] = (const GAS bf16_t*)Kb + (size_t)row * kpitch + ch * 8; kstep[i] = 64 * kpitch; }
        else { kp[i] = (const GAS bf16_t*)Kb2 + (size_t)row * k2pitch + (ch - 16) * 8; kstep[i] = 64 * k2pitch; } }
    const GAS bf16_t* vp[2];
#pragma unroll
    for (int i = 0; i < 2; ++i) { const int off = (wid * 2 + i) * 1024 + lane * 16, sub = off >> 9, rem = off & 511, kk = (sub >> 2) * 8 + (rem >> 6), kq = (kk & ~0xC) | ((kk & 4) << 1) | ((kk & 8) >> 1), c = (sub & 3) * 32 + ((rem & 63) >> 1);
        vp[i] = (const GAS bf16_t*)Vb + (size_t)kq * vpitch + c; }
    const int vstep = 64 * vpitch;
#define A_LOAD(t, bf) do { _Pragma("unroll") for (int i = 0; i < NKI; ++i) \
            __builtin_amdgcn_global_load_lds((const GAS unsigned*)(kp[i] + (size_t)(t) * kstep[i]), (LAS unsigned*)(K_lds + (bf) * SHM_K + (wid * NKI + i) * 1024), 16, 0, 0); \
        _Pragma("unroll") for (int i = 0; i < 2; ++i) \
            __builtin_amdgcn_global_load_lds((const GAS unsigned*)(vp[i] + (size_t)(t) * vstep), (LAS unsigned*)(V_lds + (bf) * SHM_V + (wid * 2 + i) * 1024), 16, 0, 0); \
        if (MODE == 1) __builtin_amdgcn_global_load_lds((const GAS unsigned*)(Fk + (t) * 64 + lane), (LAS unsigned*)(fk_l + (bf) * 64), 4, 0, 0); } while (0)
    float m_reg = -1e30f, l_reg = 0.f;
#pragma unroll
    for (int d = 0; d < 4; ++d) o[d] = f32x16{};
    const int vb00 = (int)(uintptr_t)V_lds + v_rd_base(lane);
    A_LOAD(0, 0); asm volatile("s_waitcnt vmcnt(0) lgkmcnt(0)\n\ts_barrier" ::: "memory");
    for (int t = 0; t < NT; ++t) {
        const int buf = t & 1, kb = t * 64;
        if (t + 1 < NT) A_LOAD(t + 1, buf ^ 1);
        const bool act = (MODE == 2) || (kb <= qlo + 31);
        if (act) {
            f32x16 p0 = f32x16{}, p1 = f32x16{};
            const LAS char* kbase = K_lds + buf * SHM_K + r32 * PITCH;
#pragma unroll
            for (int d0 = 0; d0 < ND; ++d0) {
                const LAS char* a = kbase + (((d0 * 32 + hi * 16) ^ ((r32 & 7) << 4)));
                const bf16x8 b0 = *(const LAS bf16x8*)a, b1 = *(const LAS bf16x8*)(a + 32 * PITCH);
                p0 = __builtin_amdgcn_mfma_f32_32x32x16_bf16(b0, qr[d0], p0, 0, 0, 0);
                p1 = __builtin_amdgcn_mfma_f32_32x32x16_bf16(b1, qr[d0], p1, 0, 0, 0);
            }
            if (MODE == 1) {
#pragma unroll
                for (int g = 0; g < 4; ++g) { const f32x4 fa = *(const LAS f32x4*)(fk_l + buf * 64 + 8 * g + 4 * hi), fb = *(const LAS f32x4*)(fk_l + buf * 64 + 32 + 8 * g + 4 * hi);
#pragma unroll
                    for (int i = 0; i < 4; ++i) { p0[4 * g + i] = fmaf(p0[4 * g + i], C2, Fq - fa[i]); p1[4 * g + i] = fmaf(p1[4 * g + i], C2, Fq - fb[i]); } }
            }
            if (MODE != 2 && kb + 63 > qlo) {
                const float NEG = -__builtin_inff(); const int dq = qlo + r32 - kb - 4 * hi;
#pragma unroll
                for (int r = 0; r < 16; ++r) { const int c = (r & 3) + 8 * (r >> 2); if (c > dq) p0[r] = NEG; if (c + 32 > dq) p1[r] = NEG; }
            }
            float pmax = p0[0];
#pragma unroll
            for (int r = 1; r < 16; ++r) pmax = fmaxf(pmax, p0[r]);
#pragma unroll
            for (int r = 0; r < 16; ++r) pmax = fmaxf(pmax, p1[r]);
            { auto rr = __builtin_amdgcn_permlane32_swap(__float_as_uint(pmax), __float_as_uint(pmax), false, false); pmax = fmaxf(__uint_as_float(rr[0]), __uint_as_float(rr[1])); }
            const float mn = fmaxf(m_reg, (MODE == 1) ? pmax : pmax * C2); const float alpha = __builtin_amdgcn_exp2f(m_reg - mn); m_reg = mn;
            float ps = 0.f;
#pragma unroll
            for (int r = 0; r < 16; ++r) { p0[r] = __builtin_amdgcn_exp2f((MODE == 1) ? p0[r] - mn : fmaf(p0[r], C2, -mn)); p1[r] = __builtin_amdgcn_exp2f((MODE == 1) ? p1[r] - mn : fmaf(p1[r], C2, -mn)); ps += p0[r] + p1[r]; }
            { auto rr = __builtin_amdgcn_permlane32_swap(__float_as_uint(ps), __float_as_uint(ps), false, false); ps = __uint_as_float(rr[0]) + __uint_as_float(rr[1]); }
            l_reg = l_reg * alpha + ps;
            bf16x8 pa0, pa1, pa2, pa3;
#define PK4(P, B_, OUT) do { unsigned a0 = cvtpk(P[B_ + 0], P[B_ + 1]), a1 = cvtpk(P[B_ + 2], P[B_ + 3]); unsigned b0 = cvtpk(P[B_ + 4], P[B_ + 5]), b1 = cvtpk(P[B_ + 6], P[B_ + 7]); \
        auto r0 = __builtin_amdgcn_permlane32_swap(a0, b0, false, false); auto r1 = __builtin_amdgcn_permlane32_swap(a1, b1, false, false); \
        u32x4 w = {r0[0], r1[0], r0[1], r1[1]}; OUT = *reinterpret_cast<bf16x8*>(&w); } while (0)
            PK4(p0, 0, pa0); PK4(p0, 8, pa1); PK4(p1, 0, pa2); PK4(p1, 8, pa3);
#undef PK4
            if (__any(alpha < 1.f)) { if (hi == 0) ws[r32] = alpha; asm volatile("s_waitcnt lgkmcnt(0)" ::: "memory");
#pragma unroll
                for (int r = 0; r < 16; ++r) { const float al = ws[crow(r, hi)];
#pragma unroll
                    for (int d = 0; d < 4; ++d) o[d][r] *= al; } }
            SBAR();
            pv_tile(o, vb00 + buf * SHM_V, pa0, pa1, pa2, pa3);
        }
        asm volatile("s_waitcnt vmcnt(0) lgkmcnt(0)\n\ts_barrier" ::: "memory");
    }
    if (hi == 0) ws[32 + r32] = l_reg; asm volatile("s_waitcnt lgkmcnt(0)" ::: "memory");
#pragma unroll
    for (int r = 0; r < 16; ++r) { const float rl = __builtin_amdgcn_rcpf(ws[32 + crow(r, hi)]);
#pragma unroll
        for (int d = 0; d < 4; ++d) o[d][r] *= rl; }
    asm volatile("s_waitcnt lgkmcnt(0)" ::: "memory");
#undef A_LOAD
}
__device__ __forceinline__ void store_o(const f32x16 (&o)[4], bf16_t* Ow, int pitch, int r32, int hi) {
#pragma unroll
    for (int r = 0; r < 16; ++r) { const int orow = crow(r, hi);
#pragma unroll
        for (int d0 = 0; d0 < 4; ++d0) { const float v = o[d0][r]; const float vn = __shfl_xor(v, 1);
            if ((r32 & 1) == 0) *(GAS unsigned*)(Ow + (size_t)orow * pitch + d0 * 32 + r32) = cvtpk(v, vn); } }
}
#undef SBAR
}

#define XB_TMO      128
#define XB_XCNT(j)  (256  + 64 * (j))
#define XB_XSUB(j)  (1280 + 64 * (j))
#define XB_XGEN(j)  (2304 + 64 * (j))
#define XB_TOP      3328
#define XB_TOPGEN   3392
#define XCD_BAR_WORDS 3456
#define XB_SPIN_CAP (1u << 20)
__device__ __forceinline__ unsigned xb_ld(unsigned* p)              { return __hip_atomic_load(p, __ATOMIC_RELAXED, __HIP_MEMORY_SCOPE_AGENT); }
__device__ __forceinline__ unsigned xb_add(unsigned* p, unsigned v) { return __hip_atomic_fetch_add(p, v, __ATOMIC_RELAXED, __HIP_MEMORY_SCOPE_AGENT); }
__device__ __forceinline__ unsigned xb_xcc_id() { return (unsigned)__builtin_amdgcn_s_getreg((3 << 11) | 20) & 0xFu; }
#define XB_SPIN(cond, bar) do { unsigned _sp = 0; while (cond) { __builtin_amdgcn_s_sleep(1); \
    if ((++_sp & 255u) == 0u) { if (xb_ld(&(bar)[XB_TMO])) break; if (_sp > XB_SPIN_CAP) { atomicAdd(&(bar)[XB_TMO], 1u); break; } } } } while (0)
struct XcdBarrier { unsigned* bar; unsigned x; volatile LAS unsigned* st; };
__device__ __forceinline__ XcdBarrier xcd_barrier_post(unsigned* bar, volatile LAS unsigned* st) {
    XcdBarrier b; b.bar = bar; b.x = xb_xcc_id(); b.st = st;
    if (threadIdx.x == 0) (void)xb_add(&bar[XB_XCNT(b.x)], 1u);
    return b;
}
__device__ __forceinline__ void xcd_barrier_complete(unsigned* bar, unsigned x, unsigned& nloc, unsigned& nx) {
    const unsigned G = gridDim.x * gridDim.y * gridDim.z;
    unsigned sum, cnt, mine, sp = 0u;
    for (;;) {
        sum = 0u; cnt = 0u; mine = 0u;
#pragma unroll
        for (unsigned j = 0; j < 16; ++j) { const unsigned c = xb_ld(&bar[XB_XCNT(j)]); sum += c; cnt += (c > 0u) ? 1u : 0u; mine = (j == x) ? c : mine; }
        if (sum == G) break;
        __builtin_amdgcn_s_sleep(1);
        if ((++sp & 255u) == 0u) { if (xb_ld(&bar[XB_TMO])) break; if (sp > XB_SPIN_CAP) { atomicAdd(&bar[XB_TMO], 1u); break; } }
    }
    nloc = mine > 0u ? mine : 1u; nx = cnt > 0u ? cnt : 1u;
}
__device__ __forceinline__ void xcd_barrier(const XcdBarrier& b) {
    asm volatile("s_waitcnt vmcnt(0)" ::: "memory");
    __syncthreads();
    if (threadIdx.x == 0) {
        unsigned* bar = b.bar;
        __builtin_amdgcn_s_waitcnt(0);
        unsigned nloc = b.st[0], nx = b.st[1];
        if (nloc == 0u) { xcd_barrier_complete(bar, b.x, nloc, nx); b.st[0] = nloc; b.st[1] = nx; }
        const unsigned old = xb_add(&bar[XB_XSUB(b.x)], 1u);
        const unsigned gen = old / nloc;
        if (old + 1u == (gen + 1u) * nloc) {
            __builtin_amdgcn_fence(__ATOMIC_RELEASE, "agent");
            asm volatile("s_waitcnt vmcnt(0)" ::: "memory");
            const unsigned og = xb_add(&bar[XB_TOP], 1u);
            const unsigned tg = og / nx;
            if (og + 1u == (tg + 1u) * nx) xb_add(&bar[XB_TOPGEN], 1u);
            else XB_SPIN(xb_ld(&bar[XB_TOPGEN]) == tg, bar);
            __builtin_amdgcn_fence(__ATOMIC_ACQUIRE, "agent");
            xb_add(&bar[XB_XGEN(b.x)], 1u);
            asm volatile("s_waitcnt vmcnt(0)" ::: "memory");
        } else {
            XB_SPIN(xb_ld(&bar[XB_XGEN(b.x)]) == gen, bar);
            __builtin_amdgcn_fence(__ATOMIC_ACQUIRE, "agent");
            asm volatile("s_waitcnt vmcnt(0)" ::: "memory");
        }
    }
    __syncthreads();
}

struct Args { const void* in[31]; float* out; unsigned char* ws; };

__device__ __forceinline__ int ropeperm64(int p) { return 4 * (p >> 3) + (p & 3) + 32 * ((p >> 2) & 1); }
__device__ __forceinline__ int ropeperm16(int w) { return 4 * (w >> 3) + (w & 3) + 8 * ((w >> 2) & 1); }
__device__ __forceinline__ int win_src(int n) {
    if (n < 1536) return n;
    if (n < 1920) return 1540 + (n - 1536);
    if (n < 2176) return 1924 + (n - 1920);
    if (n < 2240) return 2180 + ropeperm64(n - 2176);
    if (n < 2244) return 1536 + (n - 2240);
    if (n < 2304) return -1;
    if (n < 3328) return 2244 + (n - 2304);
    if (n < 4352) { const int p = n - 3328, w = p & 63; return 3268 + (p & ~63) + (w < 16 ? ropeperm16(w) : w); }
    return 4292 + (n - 4352);
}
struct TrItem { const float* W; const float* ksc; bf16_t* WT; int ldw, src, K, n0, k0; };
__device__ __forceinline__ void tr_load(const TrItem& d, f32x4 (&v)[8], int lane) {
#pragma unroll
    for (int i = 0; i < 8; ++i) { const int kk = 8 * i + (lane >> 3); v[i] = (f32x4){0.f, 0.f, 0.f, 0.f}; if (d.src >= 0) v[i] = __builtin_nontemporal_load((const GAS f32x4*)(d.W + (size_t)(d.k0 + kk) * d.ldw + d.src)); if (d.ksc) v[i] = v[i] * *(const GAS float*)(d.ksc + d.k0 + kk); }
}
__device__ __forceinline__ void tr_store(const TrItem& d, const f32x4 (&v)[8], LAS float* scr, int lane) {
#pragma unroll
    for (int i = 0; i < 8; ++i) { const int kk = 8 * i + (lane >> 3); LAS float* q = scr + kk * 33 + (lane & 7) * 4; q[0] = v[i].x; q[1] = v[i].y; q[2] = v[i].z; q[3] = v[i].w; }
    asm volatile("s_waitcnt lgkmcnt(0)" ::: "memory");
    const int c = lane & 7;
#pragma unroll
    for (int j = 0; j < 4; ++j) { const int n = (lane >> 3) + 8 * j; const LAS float* s = scr + (8 * c) * 33 + n;
        u32x4 o; o.x = pk2(s[0 * 33], s[1 * 33]); o.y = pk2(s[2 * 33], s[3 * 33]); o.z = pk2(s[4 * 33], s[5 * 33]); o.w = pk2(s[6 * 33], s[7 * 33]);
        *(GAS u32x4*)(d.WT + (size_t)(d.n0 + n) * d.K + d.k0 + 8 * c) = o; }
    asm volatile("s_waitcnt lgkmcnt(0)" ::: "memory");
}
__device__ __forceinline__ void rms_rows_bf16(const float* x, const float* g, bf16_t* out, int nrows, int gw, int ngw, int lane) {
    for (int m = gw; m < nrows; m += ngw) {
        const f32x4* xr = (const f32x4*)(x + (size_t)m * DM) + lane; f32x4 v[8]; float s = 0.f;
#pragma unroll
        for (int j = 0; j < 8; ++j) { v[j] = xr[64 * j]; s += (v[j].x * v[j].x + v[j].y * v[j].y) + (v[j].z * v[j].z + v[j].w * v[j].w); }
        const float rstd = 1.0f / sqrtf(wave_sum(s) * (1.0f / DM) + EPSN);
        u32x2* o8 = (u32x2*)(out + (size_t)m * DM) + lane;
#pragma unroll
        for (int j = 0; j < 8; ++j) { const f32x4 gj = ((const f32x4*)g)[lane + 64 * j]; u32x2 w; w.x = pk2(v[j].x * rstd * gj.x, v[j].y * rstd * gj.y); w.y = pk2(v[j].z * rstd * gj.z, v[j].w * rstd * gj.w); o8[64 * j] = w; }
    }
}

constexpr int IPL = 4864 + 144 + 128 + 2048 + 512 + 1024 + 512 + 11264 + 5632;

#define PH_IDS() const int tid = opaque_tid(), lane = tid & 63, wave = __builtin_amdgcn_readfirstlane(tid >> 6), r32 = lane & 31, hi = lane >> 5; \
    const int G = gridDim.x, gw = blockIdx.x * 8 + wave, ngw = G * 8; (void)r32; (void)hi; (void)gw; (void)ngw; (void)G
#define INP(T, k) ((const T*)launder(a.in[k]))
#define WSP(T, off) ((T*)(ws + (off)))

__device__ __forceinline__ void ph_prologue(const Args& a, char* lds) {
    PH_IDS(); unsigned char* ws = launder(a.ws);
    LAS float* scr = (LAS float*)((LAS unsigned char*)lds + wave * 16384);
    const float* w_in = INP(float, 4); const float* w_uq = INP(float, 8); const float* w_ukv = INP(float, 9); const float* w_o = INP(float, 19);
    const float* w_cq = INP(float, 22); const float* w_ck = INP(float, 23); const float* w_cv = INP(float, 24); const float* w_co = INP(float, 25);
    const float* w_gate = INP(float, 27); const float* w_up = INP(float, 28); const float* w_down = INP(float, 29);
    const float* g_cq = INP(float, 6); const float* g_ckv = INP(float, 7); const float* g_mix = INP(float, 3); const float* g_cross = INP(float, 21); const float* g_ffn = INP(float, 26);
    bf16_t* KVCW = WSP(bf16_t, WS_KVCW);
#define TR_DECODE(it_, D_) do { const int l = (it_) / IPL; int r = (it_) - l * IPL; unsigned char* lw = ws + WS_LW + (size_t)l * LW_STRIDE; const int ln = (lane & 7) * 4; int nblk; D_.ksc = nullptr; \
        if (r < 4864) { nblk = 152; D_.W = w_in + (size_t)l * DM * NIN_SRC; D_.ldw = NIN_SRC; D_.K = DM; D_.ksc = g_mix + l * DM; D_.WT = (bf16_t*)(lw + LW_WIN); D_.src = win_src((r % 152) * 32 + ln); } \
        else if ((r -= 4864) < 144) { nblk = 24; const int n = (r % 24) * 32 + ln, h = n / 192, w = n % 192; D_.src = (w < 128) ? n : h * 192 + 128 + ropeperm64(w - 128); \
            D_.W = w_uq + (size_t)l * 384 * 768; D_.ldw = 768; D_.K = 384; D_.ksc = g_cq + l * 384; D_.WT = (bf16_t*)(lw + LW_UQ); } \
        else if ((r -= 144) < 128) { nblk = 32; D_.W = w_ukv + (size_t)l * 256 * 1024; D_.ldw = 1024; D_.K = 256; D_.ksc = g_ckv + l * 256; D_.WT = (bf16_t*)(lw + LW_UKV); D_.src = (r % 32) * 32 + ln; } \
        else if ((r -= 128) < 2048) { nblk = 64; D_.W = w_o + (size_t)l * DM * DM; D_.ldw = DM; D_.K = DM; D_.WT = (bf16_t*)(lw + LW_WO); D_.src = (r % 64) * 32 + ln; } \
        else if ((r -= 2048) < 512) { nblk = 16; D_.W = w_cq + (size_t)l * DM * 512; D_.ldw = 512; D_.K = DM; D_.ksc = g_cross + l * DM; D_.WT = (bf16_t*)(lw + LW_CQ); D_.src = (r % 16) * 32 + ln; } \
        else if ((r -= 512) < 1024) { nblk = 32; const int nb = r % 32; D_.W = ((nb < 16) ? w_ck : w_cv) + (size_t)l * DM * 512; D_.ldw = 512; D_.K = DM; D_.WT = KVCW + (size_t)l * 1024 * DM; D_.src = (nb & 15) * 32 + ln; } \
        else if ((r -= 1024) < 512) { nblk = 64; D_.W = w_co + (size_t)l * 512 * DM; D_.ldw = DM; D_.K = 512; D_.WT = (bf16_t*)(lw + LW_CO); D_.src = (r % 64) * 32 + ln; } \
        else if ((r -= 512) < 11264) { nblk = 352; const int n = (r % 352) * 32, t = n >> 8, rr = n & 255; D_.W = ((rr < 128) ? w_gate : w_up) + (size_t)l * DM * FFH; D_.ldw = FFH; D_.K = DM; D_.ksc = g_ffn + l * DM; \
            D_.WT = (bf16_t*)(lw + LW_GU); D_.src = 128 * t + (rr & 127) + ln; } \
        else { r -= 11264; nblk = 64; D_.W = w_down + (size_t)l * FFH * DM; D_.ldw = DM; D_.K = FFH; D_.WT = (bf16_t*)(lw + LW_DN); D_.src = (r % 64) * 32 + ln; } \
        D_.n0 = (r % nblk) * 32; D_.k0 = (r / nblk) * 64; } while (0)
    if (gw < DEPTH * IPL) {
        TrItem cur; f32x4 v[8]; int it = gw;
        TR_DECODE(it, cur); tr_load(cur, v, lane);
        for (;;) {
            const int nx = it + ngw; const bool more = nx < DEPTH * IPL;
            TrItem nd = cur; f32x4 vn[8];
            if (more) { TR_DECODE(nx, nd); tr_load(nd, vn, lane); }
            tr_store(cur, v, scr, lane);
            if (!more) break;
            cur = nd; it = nx;
#pragma unroll
            for (int i = 0; i < 8; ++i) v[i] = vn[i];
        }
    }
#undef TR_DECODE
    const float* w_s = INP(float, 12);
    for (int i = blockIdx.x * 512 + tid; i < DEPTH * 4 * 128 * 128; i += G * 512) { const int l = i >> 16, rem = i & 65535, t = (rem >> 7) & 127, s = rem & 127;
        ((bf16_t*)(ws + WS_LW + (size_t)l * LW_STRIDE + LW_WS))[rem] = (bf16_t)f2bf(s <= t ? w_s[i] : 0.f); }
    const int* positions = INP(int, 2);
    float* COSM = WSP(float, WS_COSM); float* SINM = WSP(float, WS_SINM); float* COSD = WSP(float, WS_COSD); float* SIND = WSP(float, WS_SIND);
    for (int i = blockIdx.x * 512 + tid; i < MTOK * 40; i += G * 512) { const int row = i / 40, j = i % 40; const float pos = (float)positions[row];
        const bool isM = j < 32; const int jj = isM ? j : j - 32; const float ex = isM ? (float)jj * (1.0f / 32.0f) : (float)jj * (1.0f / 8.0f);
        const float freq = exp2f(-ex * 18.931568569324174f);
        const float ang = pos * freq; const double rev = (double)ang * 0.15915494309189535; const float fr = (float)(rev - rint(rev));
        const float c = __builtin_amdgcn_cosf(fr), sn = __builtin_amdgcn_sinf(fr);
        if (isM) { COSM[(size_t)row * 32 + jj] = c; SINM[(size_t)row * 32 + jj] = sn; } else { COSD[(size_t)row * 8 + jj] = c; SIND[(size_t)row * 8 + jj] = sn; } }
    rms_rows_bf16(INP(float, 1), INP(float, 20), WSP(bf16_t, WS_MEMN), MEMROWS, gw, ngw, lane);
    { const float* x = INP(float, 0); bf16_t* XB = WSP(bf16_t, WS_XN); float* RS0 = WSP(float, WS_RS);
      for (int m = gw; m < MTOK; m += ngw) {
        const f32x4* xr = (const f32x4*)(x + (size_t)m * DM) + lane; f32x4 v[8]; float sq = 0.f;
#pragma unroll
        for (int j = 0; j < 8; ++j) { v[j] = __builtin_nontemporal_load((const GAS f32x4*)(xr + 64 * j)); sq += (v[j].x * v[j].x + v[j].y * v[j].y) + (v[j].z * v[j].z + v[j].w * v[j].w); }
        sq = wave_sum(sq); if (lane < 8) RS0[(size_t)m * 8 + lane] = (lane == 0) ? sq : 0.f;
        u32x2* o8 = (u32x2*)(XB + (size_t)m * DM) + lane;
#pragma unroll
        for (int j = 0; j < 8; ++j) { u32x2 w; w.x = pk2(v[j].x, v[j].y); w.y = pk2(v[j].z, v[j].w); o8[64 * j] = w; }
      } }
}

__device__ __forceinline__ void sgu_unit(const Args& a, char* lds, int l, int u) {
    PH_IDS(); unsigned char* ws = launder(a.ws);
    const bf16_t* P = WSP(bf16_t, WS_P); bf16_t* MIX = WSP(bf16_t, WS_MIX);
    const bf16_t* WSb = (const bf16_t*)(ws + WS_LW + (size_t)l * LW_STRIDE + LW_WS);
    const float* sgu_g = INP(float, 10); const float* sgu_b = INP(float, 11); const float* b_s = INP(float, 13);
    {
        const int g = u & 3, bn = u >> 2; const size_t row0 = (size_t)bn * 128;
        LAS char* Vt = (LAS char*)lds;
        const bool mine = (lane >> 4) == g; const int cl = (lane & 15) * 8;
        float gg[8], bb[8];
#pragma unroll
        for (int k = 0; k < 8; ++k) { gg[k] = sgu_g[l * 512 + g * 128 + cl + k]; bb[k] = sgu_b[l * 512 + g * 128 + cl + k]; }
        for (int i = 0; i < 16; i += 2) { const int s0 = wave * 16 + i, s1 = s0 + 1;
            const bf16x8 va = *(const GAS bf16x8*)(P + (row0 + s0) * NIN + PC_V + lane * 8), vb = *(const GAS bf16x8*)(P + (row0 + s1) * NIN + PC_V + lane * 8);
            float za[8], zb[8]; float suma = 0.f, sqa = 0.f, sumb = 0.f, sqb = 0.f;
#pragma unroll
            for (int k = 0; k < 8; ++k) { za[k] = gelu_tanh(bf2f((unsigned short)va[k])); zb[k] = gelu_tanh(bf2f((unsigned short)vb[k])); suma += za[k]; sqa += za[k] * za[k]; sumb += zb[k]; sqb += zb[k] * zb[k]; }
#pragma unroll
            for (int o = 1; o < 64; o <<= 1) { const float t0 = __shfl_xor(suma, o), t1 = __shfl_xor(sqa, o), t2 = __shfl_xor(sumb, o), t3 = __shfl_xor(sqb, o); suma += t0; sqa += t1; sumb += t2; sqb += t3; }
            const float meana = suma * (1.0f / 512.0f), meanb = sumb * (1.0f / 512.0f);
            const float rstda = 1.0f / sqrtf(fmaxf(sqa * (1.0f / 512.0f) - meana * meana, 0.f) + EPSN), rstdb = 1.0f / sqrtf(fmaxf(sqb * (1.0f / 512.0f) - meanb * meanb, 0.f) + EPSN);
            if (mine) {
#pragma unroll
                for (int k = 0; k < 8; ++k) { *(LAS bf16_t*)(Vt + (cl + k) * 272 + s0 * 2) = (bf16_t)f2bf((za[k] - meana) * rstda * gg[k] + bb[k]);
                                              *(LAS bf16_t*)(Vt + (cl + k) * 272 + s1 * 2) = (bf16_t)f2bf((zb[k] - meanb) * rstdb * gg[k] + bb[k]); } } }
        __syncthreads();
        const int tb = wave & 3, cb0 = (wave >> 2) * 2; f32x16 acc[2]; acc[0] = f32x16{}; acc[1] = f32x16{};
#pragma unroll
        for (int ks = 0; ks < 8; ++ks) if (16 * ks <= 32 * tb + 31) {
            const bf16x8 A = *(const bf16x8*)(WSb + ((size_t)g * 128 + 32 * tb + r32) * 128 + 16 * ks + 8 * hi);
#pragma unroll
            for (int ci = 0; ci < 2; ++ci) { const bf16x8 B = *(const LAS bf16x8*)(Vt + (32 * (cb0 + ci) + r32) * 272 + (16 * ks + 8 * hi) * 2); acc[ci] = __builtin_amdgcn_mfma_f32_32x32x16_bf16(A, B, acc[ci], 0, 0, 0); } }
#pragma unroll
        for (int ci = 0; ci < 2; ++ci)
#pragma unroll
            for (int r = 0; r < 16; ++r) { const int t = 32 * tb + crow(r, hi), c = 32 * (cb0 + ci) + r32; const size_t row = row0 + t;
                const float uval = gelu_tanh(bf2f(P[row * NIN + PC_U + g * 128 + c])); const float val = uval * (acc[ci][r] + b_s[l * 512 + g * 128 + t]);
                const float vn = __shfl_xor(val, 1); if ((r32 & 1) == 0) *(unsigned*)(MIX + row * DM + 1024 + g * 128 + c) = cvtpk(val, vn); }
        __syncthreads();
    }
}

__device__ __forceinline__ void ph_misc(const Args& a, char* lds, int l) {
    PH_IDS(); unsigned char* ws = launder(a.ws);
    const bf16_t* P = WSP(bf16_t, WS_P); bf16_t* MIX = WSP(bf16_t, WS_MIX);
    const float* FF = WSP(float, WS_FF); float* CUMF = WSP(float, WS_CUMF);
    if (wave == 0) {
#pragma unroll 1
        for (int b = 0; b < NB; ++b) {
            const int owner = (G >= 256) ? 192 + 8 * b : b % G;
            if ((int)blockIdx.x != owner) continue;
            const f32x4 bf = *(const f32x4*)(INP(float, 5) + l * 4); float c0 = 0.f, c1 = 0.f, c2 = 0.f, c3 = 0.f;
#pragma unroll 4
            for (int jj = 0; jj < SEQ / 64; ++jj) { const int pos = jj * 64 + lane; const f32x4 y = *(const GAS f32x4*)(FF + (size_t)(b * SEQ + pos) * 4) + bf;
                float s0 = fminf(y.x, 0.f) - __logf(1.0f + __expf(-fabsf(y.x))), s1 = fminf(y.y, 0.f) - __logf(1.0f + __expf(-fabsf(y.y)));
                float s2 = fminf(y.z, 0.f) - __logf(1.0f + __expf(-fabsf(y.z))), s3 = fminf(y.w, 0.f) - __logf(1.0f + __expf(-fabsf(y.w)));
#pragma unroll
                for (int o = 1; o < 64; o <<= 1) { const float t0 = __shfl_up(s0, o), t1 = __shfl_up(s1, o), t2 = __shfl_up(s2, o), t3 = __shfl_up(s3, o); if (lane >= o) { s0 += t0; s1 += t1; s2 += t2; s3 += t3; } }
                *(GAS float*)(CUMF + (size_t)(b * 4 + 0) * SEQ + pos) = (c0 + s0) * LOG2E; *(GAS float*)(CUMF + (size_t)(b * 4 + 1) * SEQ + pos) = (c1 + s1) * LOG2E;
                *(GAS float*)(CUMF + (size_t)(b * 4 + 2) * SEQ + pos) = (c2 + s2) * LOG2E; *(GAS float*)(CUMF + (size_t)(b * 4 + 3) * SEQ + pos) = (c3 + s3) * LOG2E;
                c0 += __shfl(s0, 63); c1 += __shfl(s1, 63); c2 += __shfl(s2, 63); c3 += __shfl(s3, 63); }
        }
    }
}

__device__ __forceinline__ void ph_attn(const Args& a, char* lds, int l, int rep) {
    PH_IDS(); unsigned char* ws = launder(a.ws);
    const bf16_t* P = WSP(bf16_t, WS_P); bf16_t* MIX = WSP(bf16_t, WS_MIX);
    volatile LAS unsigned* ldsctl = (volatile LAS unsigned*)((LAS char*)lds + LDSCTL_OFF);
    const float lam_init = 0.8f - 0.6f * expf(-0.3f * (float)l);
    const float* lq1 = INP(float, 14); const float* lk1 = INP(float, 15); const float* lq2 = INP(float, 16); const float* lk2 = INP(float, 17);
    float d1 = 0.f, d2 = 0.f;
    for (int i = 0; i < 64; ++i) { d1 += lq1[l * 64 + i] * lk1[l * 64 + i]; d2 += lq2[l * 64 + i] * lk2[l * 64 + i]; }
    const float lam = expf(d1) - expf(d2) + lam_init;
    unsigned* ctr = WSP(unsigned, WS_CTL) + 64 * (1 + l + 8 * rep);
    int ulast = 768 + 512;
    for (;;) {
        if (tid == 0) ldsctl[0] = atomicAdd(ctr, 1u);
        __syncthreads();
        const int u = (int)ldsctl[0];
        __syncthreads();
        if (u >= 768) { ulast = u; break; }
        const int qb = 7 - u / 96, within = u % 96, type = within >> 5, bh = within & 31, b = bh >> 2, h = bh & 3;
        const size_t brow = (size_t)b * SEQ, qrow = brow + qb * 256 + wave * 32; const int qlo = qb * 256 + wave * 32, NT = 4 * (qb + 1);
        f32x16 o[4];
#ifndef SK_FOX
        if (type == 2) {
            const float* Fk = WSP(float, WS_CUMF) + (size_t)bh * SEQ;
            att::attn_pass<128, 1>((LAS char*)lds, P + qrow * NIN + PC_FQ + h * 128, NIN, P + brow * NIN + PC_FK + h * 128, NIN, nullptr, 0, P + brow * NIN + PC_FV + h * 128, NIN,
                                   Fk, Fk[qlo + r32], NT, qlo, 0.08838834764831845f * LOG2E, o);
            att::store_o(o, MIX + qrow * DM + h * 128, DM, r32, hi);
        } else
#endif
#ifndef SK_MLA
        if (type == 1) {
            const bf16_t* QM = WSP(bf16_t, WS_QM); const bf16_t* KVM = WSP(bf16_t, WS_KVM);
            att::attn_pass<192, 0>((LAS char*)lds, QM + qrow * 768 + h * 192, 768, KVM + brow * 1024 + h * 256, 1024, P + brow * NIN + PC_KR, NIN, KVM + brow * 1024 + h * 256 + 128, 1024,
                                   nullptr, 0.f, NT, qlo, 0.07216878364870322f * LOG2E, o);
            att::store_o(o, MIX + qrow * DM + 512 + h * 128, DM, r32, hi);
        } else
#endif
#ifndef SK_DIFF
        {
            unsigned o1p[4][8];
            att::attn_pass<64, 0>((LAS char*)lds, P + qrow * NIN + PC_DQ + h * 128, NIN, P + brow * NIN + PC_DK + h * 128, NIN, nullptr, 0, P + brow * NIN + PC_DV + h * 128, NIN,
                                  nullptr, 0.f, NT, qlo, 0.125f * LOG2E, o);
#pragma unroll
            for (int d = 0; d < 4; ++d)
#pragma unroll
                for (int r = 0; r < 8; ++r) o1p[d][r] = cvtpk(o[d][2 * r], o[d][2 * r + 1]);
            att::attn_pass<64, 0>((LAS char*)lds, P + qrow * NIN + PC_DQ + h * 128 + 64, NIN, P + brow * NIN + PC_DK + h * 128 + 64, NIN, nullptr, 0, P + brow * NIN + PC_DV + h * 128, NIN,
                                  nullptr, 0.f, NT, qlo, 0.125f * LOG2E, o);
            const float* g_diff = INP(float, 18);
            float gd[4];
#pragma unroll
            for (int d = 0; d < 4; ++d) gd[d] = g_diff[l * 128 + d * 32 + r32] * (1.0f - lam_init);
#pragma unroll
            for (int r = 0; r < 16; ++r) { float ss = 0.f;
#pragma unroll
                for (int d = 0; d < 4; ++d) { const unsigned pw = o1p[d][r >> 1]; const float o1v = __uint_as_float((r & 1) ? (pw & 0xffff0000u) : (pw << 16)); const float v = o1v - lam * o[d][r]; o[d][r] = v; ss += v * v; }
                ss += __shfl_xor(ss, 1); ss += __shfl_xor(ss, 2); ss += __shfl_xor(ss, 4); ss += __shfl_xor(ss, 8); ss += __shfl_xor(ss, 16);
                const float rs = 1.0f / sqrtf(ss * (1.0f / 128.0f) + EPSN);
#pragma unroll
                for (int d = 0; d < 4; ++d) o[d][r] *= rs * gd[d]; }
            att::store_o(o, MIX + qrow * DM + 1536 + h * 128, DM, r32, hi);
        }
#else
        {}
#endif
    }
    for (int u = ulast; u < 768 + 512;) {
        sgu_unit(a, lds, l, u - 768);
        if (tid == 0) ldsctl[0] = atomicAdd(ctr, 1u);
        __syncthreads();
        u = (int)ldsctl[0];
        __syncthreads();
    }
}

__device__ __forceinline__ void ph_cross(const Args& a, char* lds, int l) {
    PH_IDS(); unsigned char* ws = launder(a.ws);
    const bf16_t* QC = WSP(bf16_t, WS_QC); const bf16_t* KVC = WSP(bf16_t, WS_KVC); bf16_t* OC = WSP(bf16_t, WS_OC);
    for (int u = blockIdx.x; u < 256; u += G) {
        const int qb = u & 7, bh = u >> 3, b = bh >> 2, h = bh & 3; const size_t qrow = (size_t)b * SEQ + qb * 256 + wave * 32;
        f32x16 o[4];
        att::attn_pass<128, 2>((LAS char*)lds, QC + qrow * 512 + h * 128, 512, KVC + (size_t)b * MEMLEN * 4096 + l * 1024 + h * 128, 4096, nullptr, 0,
                               KVC + (size_t)b * MEMLEN * 4096 + l * 1024 + 512 + h * 128, 4096, nullptr, 0.f, 4, 0, 0.08838834764831845f * LOG2E, o);
        att::store_o(o, OC + qrow * 512 + h * 128, 512, r32, hi);
    }
}
__device__ __forceinline__ void ph_norm(const Args& a, const float* x, int gidx, int l) {
    PH_IDS(); unsigned char* ws = launder(a.ws);
    rms_rows_bf16(x, INP(float, gidx) + (size_t)l * DM, WSP(bf16_t, WS_XN), MTOK, gw, ngw, lane);
}
__device__ __forceinline__ void ph_final(const Args& a) {
    PH_IDS(); float* outp = launder(a.out); const float* g_final = INP(float, 30); unsigned char* ws = launder(a.ws); const bf16_t* XB = WSP(bf16_t, WS_XN);
    for (int m = gw; m < MTOK; m += ngw) {
        const GAS u32x2* xr = (const GAS u32x2*)(XB + (size_t)m * DM) + lane; f32x4 v[8]; float s = 0.f;
#pragma unroll
        for (int j = 0; j < 8; ++j) { const u32x2 p = xr[64 * j]; v[j] = (f32x4){__uint_as_float(p.x << 16), __uint_as_float(p.x & 0xffff0000u), __uint_as_float(p.y << 16), __uint_as_float(p.y & 0xffff0000u)};
            s += (v[j].x * v[j].x + v[j].y * v[j].y) + (v[j].z * v[j].z + v[j].w * v[j].w); }
        const float rstd = 1.0f / sqrtf(wave_sum(s) * (1.0f / DM) + EPSN);
        GAS f32x4* o = (GAS f32x4*)(outp + (size_t)m * DM) + lane;
#pragma unroll
        for (int j = 0; j < 8; ++j) { const f32x4 gj = ((const f32x4*)g_final)[lane + 64 * j]; __builtin_nontemporal_store(v[j] * rstd * gj, o + 64 * j); }
    }
}

__global__ void __launch_bounds__(512, 2) fwd_kernel(Args a) {
    extern __shared__ __attribute__((aligned(16))) unsigned char lds_raw[];
    cg::grid_group grid = cg::this_grid();
    const int G = gridDim.x;
    LAS unsigned char* ldsL = (LAS unsigned char*)lds_raw;
    char* lds = (char*)lds_raw;
    { volatile LAS unsigned* z = (volatile LAS unsigned*)(ldsL + LDSCTL_OFF); if (threadIdx.x < 64) z[threadIdx.x] = 0u; }
    __syncthreads();
    (void)xcd_barrier_post((unsigned*)(launder(a.ws) + WS_CTL) + 4096, (volatile LAS unsigned*)(ldsL + LDSCTL_OFF) + 8);
#define GRID_BAR() do { XcdBarrier bar_; bar_.bar = (unsigned*)(launder(a.ws) + WS_CTL) + 4096; bar_.x = xb_xcc_id(); bar_.st = (volatile LAS unsigned*)(launder(ldsL) + LDSCTL_OFF) + 8; xcd_barrier(bar_); } while (0)
#ifndef SK_P0
    ph_prologue(a, lds);
#endif
    if (gridDim.y == 0x7fffu) grid.sync();
    GRID_BAR();
    for (int rep = 0; rep < DUP_PRO; ++rep) { ph_prologue(a, lds); GRID_BAR(); }
    for (int l = 0; l < DEPTH; ++l) {
        for (int rep = 0; rep <= DUP_G; ++rep) {
        { unsigned char* ws = launder(a.ws); unsigned char* lw = ws + WS_LW + (size_t)l * LW_STRIDE;
          EpiBf16G E{WSP(bf16_t, WS_P), NIN, WSP(float, WS_RS) + (size_t)(3 * l) * MTOK * 8, 1.0f / DM, 1, 1, WSP(float, WS_COSM), WSP(float, WS_SINM), WSP(float, WS_COSD), WSP(float, WS_SIND), WSP(float, WS_FF)};
          run_gemm(ldsL, WSP(bf16_t, WS_XN), DM, (const bf16_t*)(lw + LW_WIN), DM, MTOK, NIN, DM, E); }
        if (rep < DUP_G) GRID_BAR(); }
        GRID_BAR();
#ifndef SK_P3
        ph_misc(a, lds, l);
#endif
        for (int rep = 0; rep <= DUP_G; ++rep) {
        { unsigned char* ws = launder(a.ws); unsigned char* lw = ws + WS_LW + (size_t)l * LW_STRIDE;
          EpiLat<12, true> E{WSP(bf16_t, WS_QM), 768, WSP(float, WS_RSQ), 1.0f / 384.0f, WSP(float, WS_COSM), WSP(float, WS_SINM)};
          run_gemm(ldsL, WSP(bf16_t, WS_P) + PC_CQ, NIN, (const bf16_t*)(lw + LW_UQ), 384, MTOK, 768, 384, E); }
        { unsigned char* ws = launder(a.ws); unsigned char* lw = ws + WS_LW + (size_t)l * LW_STRIDE;
          EpiLat<8, false> E{WSP(bf16_t, WS_KVM), 1024, WSP(float, WS_RSKV), 1.0f / 256.0f, nullptr, nullptr};
          run_gemm(ldsL, WSP(bf16_t, WS_P) + PC_CKV, NIN, (const bf16_t*)(lw + LW_UKV), 256, MTOK, 1024, 256, E); }
        if (rep < DUP_G) GRID_BAR(); }
        GRID_BAR();
        ph_attn(a, lds, l, 0);
        GRID_BAR();
        for (int rep = 1; rep <= DUP_ATT; ++rep) { ph_attn(a, lds, l, rep); GRID_BAR(); }
        for (int e = 0; e < EXTRA_SYNC; ++e) GRID_BAR();
        { unsigned char* ws = launder(a.ws); unsigned char* lw = ws + WS_LW + (size_t)l * LW_STRIDE;
          EpiRes E{WSP(bf16_t, WS_XN), DM, WSP(float, WS_RS) + (size_t)(3 * l + 1) * MTOK * 8, (LAS float*)(ldsL + LDSP_OFF)}; run_gemm(ldsL, WSP(bf16_t, WS_MIX), DM, (const bf16_t*)(lw + LW_WO), DM, MTOK, DM, DM, E); }
        GRID_BAR();
        for (int rep = 0; rep <= DUP_G; ++rep) {
        { unsigned char* ws = launder(a.ws); unsigned char* lw = ws + WS_LW + (size_t)l * LW_STRIDE;
          EpiBf16G E{WSP(bf16_t, WS_QC), 512, WSP(float, WS_RS) + (size_t)(3 * l + 1) * MTOK * 8, 1.0f / DM, 0, 1, nullptr, nullptr, nullptr, nullptr, nullptr}; if (l == 0 && G >= 256 && blockIdx.x >= 128) {
              EpiBf16G E2{WSP(bf16_t, WS_KVC), 4096, nullptr, 0.f, 0, 0, nullptr, nullptr, nullptr, nullptr, nullptr};
              pg8::Gemm g2{WSP(bf16_t, WS_MEMN), WSP(bf16_t, WS_KVCW), MEMROWS, 4096, DM, DM, DM}; pg8::StaticOrder S2; S2.init(MEMROWS, 4096, 128, (int)blockIdx.x - 128);
              pg8::gemm_phase<EpiBf16G, pg8::StaticOrder>(ldsL, g2, S2, E2);
          } else if (l == 0 && G < 256) {
              EpiBf16G E2{WSP(bf16_t, WS_KVC), 4096, nullptr, 0.f, 0, 0, nullptr, nullptr, nullptr, nullptr, nullptr};
              run_gemm(ldsL, WSP(bf16_t, WS_MEMN), DM, WSP(bf16_t, WS_KVCW), DM, MEMROWS, 4096, DM, E2); run_gemm(ldsL, WSP(bf16_t, WS_XN), DM, (const bf16_t*)(lw + LW_CQ), DM, MTOK, 512, DM, E);
          } else run_gemm(ldsL, WSP(bf16_t, WS_XN), DM, (const bf16_t*)(lw + LW_CQ), DM, MTOK, 512, DM, E); }
        if (rep < DUP_G) GRID_BAR(); }
        GRID_BAR();
#ifndef SK_P9
        ph_cross(a, lds, l);
        for (int rep = 0; rep < DUP_P9; ++rep) { GRID_BAR(); ph_cross(a, lds, l); }
#endif
        GRID_BAR();
        { unsigned char* ws = launder(a.ws); unsigned char* lw = ws + WS_LW + (size_t)l * LW_STRIDE;
          EpiRes E{WSP(bf16_t, WS_XN), DM, WSP(float, WS_RS) + (size_t)(3 * l + 2) * MTOK * 8, (LAS float*)(ldsL + LDSP_OFF)}; run_gemm(ldsL, WSP(bf16_t, WS_OC), 512, (const bf16_t*)(lw + LW_CO), 512, MTOK, DM, 512, E); }
        GRID_BAR();
        for (int rep = 0; rep <= DUP_P12; ++rep) {
        { unsigned char* ws = launder(a.ws); unsigned char* lw = ws + WS_LW + (size_t)l * LW_STRIDE;
          EpiSwiglu E{WSP(bf16_t, WS_HID), FFH, WSP(float, WS_RS) + (size_t)(3 * l + 2) * MTOK * 8}; run_gemm(ldsL, WSP(bf16_t, WS_XN), DM, (const bf16_t*)(lw + LW_GU), DM, MTOK, 2 * FFH, DM, E); }
        if (rep < DUP_P12) GRID_BAR(); }
        GRID_BAR();
        { unsigned char* ws = launder(a.ws); unsigned char* lw = ws + WS_LW + (size_t)l * LW_STRIDE;
          EpiRes E{WSP(bf16_t, WS_XN), DM, WSP(float, WS_RS) + (size_t)(l + 1 < DEPTH ? 3 * l + 3 : 1) * MTOK * 8, (LAS float*)(ldsL + LDSP_OFF)}; run_gemm(ldsL, WSP(bf16_t, WS_HID), FFH, (const bf16_t*)(lw + LW_DN), FFH, MTOK, DM, FFH, E); }
        GRID_BAR();
    }
    ph_final(a);
}

extern "C" void kernel_launch(void* const* d_in, const int* in_sizes, int n_in, void* d_out, int out_size, void* d_ws, size_t ws_size, hipStream_t stream) {
    static int grid = 0;
    if (grid == 0) {
        if (n_in != 31 || out_size != MTOK * DM || ws_size < WS_END) { fprintf(stderr, "kernel_launch: unexpected shapes (n_in %d out %d ws %zu need %zu)\n", n_in, out_size, ws_size, (size_t)WS_END); grid = -1; return; }
        int dev = 0, cus = 0, per_cu = 0;
        (void)hipGetDevice(&dev);
        (void)hipDeviceGetAttribute(&cus, hipDeviceAttributeMultiprocessorCount, dev);
        (void)hipFuncSetAttribute((const void*)fwd_kernel, hipFuncAttributeMaxDynamicSharedMemorySize, LDS_BYTES);
        (void)hipOccupancyMaxActiveBlocksPerMultiprocessor(&per_cu, (const void*)fwd_kernel, 512, LDS_BYTES);
        if (per_cu < 1) { fprintf(stderr, "kernel_launch: occupancy query says %d blocks per CU\n", per_cu); per_cu = 1; }
        grid = cus > 0 ? cus : 256;
    }
    if (grid < 0) return;
    (void)hipMemsetAsync((char*)d_ws + WS_CTL, 0, 65536, stream);
    Args a{};
    for (int i = 0; i < 31; ++i) a.in[i] = d_in[i];
    a.out = (float*)d_out; a.ws = (unsigned char*)d_ws;
    void* args[] = {&a};
    hipError_t e = hipLaunchCooperativeKernel((const void*)fwd_kernel, dim3(grid), dim3(512), args, LDS_BYTES, stream);
    if (e != hipSuccess) fprintf(stderr, "cooperative launch failed: %s (grid %d)\n", hipGetErrorString(e), grid);
}
```
